# Optimizing an MI355X kernel written in HIP

```python
import jax, jax.numpy as jnp
from jax import lax
import numpy as np

D_MODEL = 1024
BATCH = 8
SEQ = 4096
DEPTH = 2

N_A_LAYERS = DEPTH // 2
N_B_LAYERS = DEPTH - N_A_LAYERS
HGRN_EXPAND = 128
HGRN_HEADS = D_MODEL // HGRN_EXPAND
HGRN_DK = HGRN_EXPAND
HGRN_DV = D_MODEL // HGRN_HEADS
HGRN_CHUNK = 64
MLA_HEADS = 16
MLA_NOPE = 128
MLA_ROPE = 64
MLA_V = 128
MLA_Q_LORA = 256
MLA_KV_LORA = 256
ROPE_THETA = 10000.0
QBLOCK = 128
D_FF = 4 * D_MODEL
EPS = 1e-6

kernel_name = 'hybrid_hgrn2_mla_yoco'


def rmsnorm(x, gain):
    xf = x.astype(jnp.float32)
    y = xf * lax.rsqrt(jnp.mean(xf * xf, axis=-1, keepdims=True) + EPS)
    return (y * gain.astype(jnp.float32)).astype(x.dtype)


def rope_tables(seq):
    half = MLA_ROPE // 2
    inv_freq = ROPE_THETA ** (-jnp.arange(half, dtype=jnp.float32) / half)
    ang = jnp.arange(seq, dtype=jnp.float32)[:, None] * inv_freq[None, :]
    return jnp.cos(ang), jnp.sin(ang)


def apply_rope(x, cos, sin):
    half = MLA_ROPE // 2
    xf = x.astype(jnp.float32)
    x1, x2 = xf[..., :half], xf[..., half:]
    return jnp.concatenate([x1 * cos - x2 * sin, x2 * cos + x1 * sin], axis=-1).astype(x.dtype)


def hgrn_lower_bounds(lb_logits):
    return jnp.cumsum(jax.nn.softmax(lb_logits.astype(jnp.float32), axis=0), axis=0)


def hgrn2_mixer(xn, w_q, w_f, w_i, w_g, g_norm, w_o, lb):
    bsz, seq, _ = xn.shape
    nc = seq // HGRN_CHUNK
    f32 = jnp.float32
    q = jax.nn.silu((xn @ w_q).astype(f32))
    forget = lb + (1.0 - lb) * jax.nn.sigmoid((xn @ w_f).astype(f32))
    log_f = jnp.log(forget)
    k = 1.0 - forget
    v = (xn @ w_i).astype(f32)

    def chunks(t, d):
        return t.reshape(bsz, nc, HGRN_CHUNK, HGRN_HEADS, d).transpose(1, 0, 3, 2, 4)

    causal = jnp.tril(jnp.ones((HGRN_CHUNK, HGRN_CHUNK), dtype=bool))

    def step(state, inp):
        qc, kc, vc, gc = inp
        b = jnp.cumsum(gc, axis=2)
        o_inter = jnp.einsum('bhtd,bhdv->bhtv', qc * jnp.exp(b), state)
        diff = b[:, :, :, None, :] - b[:, :, None, :, :]
        decay = jnp.exp(jnp.where(causal[:, :, None], diff, -jnp.inf))
        scores = jnp.einsum('bhtd,bhsd,bhtsd->bhts', qc, kc, decay)
        o_intra = jnp.einsum('bhts,bhsv->bhtv', scores, vc)
        b_last = b[:, :, -1:, :]
        new_state = jnp.exp(b_last[:, :, 0, :])[..., None] * state + jnp.einsum(
            'bhsd,bhsv->bhdv', kc * jnp.exp(b_last - b), vc)
        return new_state, o_inter + o_intra

    state0 = jnp.zeros((bsz, HGRN_HEADS, HGRN_DK, HGRN_DV), f32)
    _, o = lax.scan(step, state0, (chunks(q, HGRN_DK), chunks(k, HGRN_DK),
                                   chunks(v, HGRN_DV), chunks(log_f, HGRN_DK)))
    o = o.transpose(1, 0, 3, 2, 4).reshape(bsz, seq, HGRN_HEADS, HGRN_DV)
    o = rmsnorm(o, g_norm)
    gate = jax.nn.silu((xn @ w_g).astype(f32)).reshape(bsz, seq, HGRN_HEADS, HGRN_DV)
    o = (o * gate).reshape(bsz, seq, D_MODEL).astype(xn.dtype)
    return o @ w_o


def shared_mla_kv(h, in_norm, w_dkv, kv_norm, w_uk, w_uv, cos, sin):
    bsz, seq, _ = h.shape
    hn = rmsnorm(h, in_norm)
    ckr = hn @ w_dkv
    c_kv = rmsnorm(ckr[..., :MLA_KV_LORA], kv_norm)
    k_rope = apply_rope(ckr[..., MLA_KV_LORA:], cos, sin)
    k_nope = (c_kv @ w_uk).reshape(bsz, seq, MLA_HEADS, MLA_NOPE)
    v = (c_kv @ w_uv).reshape(bsz, seq, MLA_HEADS, MLA_V)
    return k_nope, k_rope, v


def mla_mixer(xn, w_dq, q_norm, w_uq, w_o, k_nope, k_rope, v, cos, sin):
    bsz, seq, _ = xn.shape
    nb = seq // QBLOCK
    c_q = rmsnorm(xn @ w_dq, q_norm)
    q = (c_q @ w_uq).reshape(bsz, seq, MLA_HEADS, MLA_NOPE + MLA_ROPE)
    q_nope = q[..., :MLA_NOPE]
    q_rope = apply_rope(q[..., MLA_NOPE:], cos[:, None, :], sin[:, None, :])
    qn_b = q_nope.reshape(bsz, nb, QBLOCK, MLA_HEADS, MLA_NOPE).transpose(1, 0, 2, 3, 4)
    qr_b = q_rope.reshape(bsz, nb, QBLOCK, MLA_HEADS, MLA_ROPE).transpose(1, 0, 2, 3, 4)
    starts = jnp.arange(nb, dtype=jnp.int32) * QBLOCK
    key_pos = jnp.arange(seq, dtype=jnp.int32)
    scale = (MLA_NOPE + MLA_ROPE) ** -0.5

    def block(args):
        qn, qr, start = args
        s = jnp.einsum('bqhd,bkhd->bhqk', qn, k_nope) + jnp.einsum('bqhr,bkr->bhqk', qr, k_rope)
        s = s.astype(jnp.float32) * scale
        q_pos = start + jnp.arange(QBLOCK, dtype=jnp.int32)
        s = jnp.where(key_pos[None, :] <= q_pos[:, None], s, -jnp.inf)
        p = jax.nn.softmax(s, axis=-1).astype(v.dtype)
        return jnp.einsum('bhqk,bkhv->bqhv', p, v)

    o = lax.map(block, (qn_b, qr_b, starts))
    o = o.transpose(1, 0, 2, 3, 4).reshape(bsz, seq, MLA_HEADS * MLA_V)
    return o @ w_o


def sq_relu_mlp(xn, w_up, w_down):
    return jnp.square(jax.nn.relu(xn @ w_up)) @ w_down


def setup_inputs(seed: int = 0) -> dict:
    key = jax.random.key(seed)
    ks = jax.random.split(key, 24)
    f32 = jnp.float32

    def w(k, shape, fan_in):
        return jax.random.normal(k, shape, f32) * (fan_in ** -0.5)

    def gain(k, shape):
        return 1.0 + 0.02 * jax.random.normal(k, shape, f32)

    D = D_MODEL
    return {
        'x': jax.random.normal(ks[0], (BATCH, SEQ, D), f32),
        'hgrn_norm': gain(ks[1], (N_A_LAYERS, D)),
        'hgrn_w_q': w(ks[2], (N_A_LAYERS, D, D), D),
        'hgrn_w_f': w(ks[3], (N_A_LAYERS, D, D), D),
        'hgrn_w_i': w(ks[4], (N_A_LAYERS, D, D), D),
        'hgrn_w_g': w(ks[5], (N_A_LAYERS, D, D), D),
        'hgrn_g_norm': gain(ks[6], (N_A_LAYERS, HGRN_DV)),
        'hgrn_w_o': w(ks[7], (N_A_LAYERS, D, D), D),
        'hgrn_lb_logits': 0.5 * jax.random.normal(ks[8], (N_A_LAYERS + 1, D), f32),
        'mla_norm': gain(ks[9], (N_B_LAYERS, D)),
        'mla_w_dq': w(ks[10], (N_B_LAYERS, D, MLA_Q_LORA), D),
        'mla_q_norm': gain(ks[11], (N_B_LAYERS, MLA_Q_LORA)),
        'mla_w_uq': w(ks[12], (N_B_LAYERS, MLA_Q_LORA, MLA_HEADS * (MLA_NOPE + MLA_ROPE)), MLA_Q_LORA),
        'mla_w_o': w(ks[13], (N_B_LAYERS, MLA_HEADS * MLA_V, D), MLA_HEADS * MLA_V),
        'kv_in_norm': gain(ks[14], (D,)),
        'kv_w_dkv': w(ks[15], (D, MLA_KV_LORA + MLA_ROPE), D),
        'kv_norm': gain(ks[16], (MLA_KV_LORA,)),
        'kv_w_uk': w(ks[17], (MLA_KV_LORA, MLA_HEADS * MLA_NOPE), MLA_KV_LORA),
        'kv_w_uv': w(ks[18], (MLA_KV_LORA, MLA_HEADS * MLA_V), MLA_KV_LORA),
        'mlp_norm': gain(ks[19], (DEPTH, D)),
        'mlp_w_up': w(ks[20], (DEPTH, D, D_FF), D),
        'mlp_w_down': w(ks[21], (DEPTH, D_FF, D), D_FF),
        'final_norm': gain(ks[22], (D,)),
    }


def reference(x, hgrn_norm, hgrn_w_q, hgrn_w_f, hgrn_w_i, hgrn_w_g, hgrn_g_norm, hgrn_w_o,
              hgrn_lb_logits, mla_norm, mla_w_dq, mla_q_norm, mla_w_uq, mla_w_o,
              kv_in_norm, kv_w_dkv, kv_norm, kv_w_uk, kv_w_uv,
              mlp_norm, mlp_w_up, mlp_w_down, final_norm):
    seq = x.shape[1]
    cos, sin = rope_tables(seq)
    lower_bounds = hgrn_lower_bounds(hgrn_lb_logits)
    h = x
    k_nope = k_rope = v = None
    for l in range(DEPTH):
        if l < N_A_LAYERS:
            h = h + hgrn2_mixer(rmsnorm(h, hgrn_norm[l]), hgrn_w_q[l], hgrn_w_f[l], hgrn_w_i[l],
                                hgrn_w_g[l], hgrn_g_norm[l], hgrn_w_o[l], lower_bounds[l])
        else:
            j = l - N_A_LAYERS
            h = h + mla_mixer(rmsnorm(h, mla_norm[j]), mla_w_dq[j], mla_q_norm[j], mla_w_uq[j],
                              mla_w_o[j], k_nope, k_rope, v, cos, sin)
        h = h + sq_relu_mlp(rmsnorm(h, mlp_norm[l]), mlp_w_up[l], mlp_w_down[l])
        if l == N_A_LAYERS - 1:
            k_nope, k_rope, v = shared_mla_kv(h, kv_in_norm, kv_w_dkv, kv_norm, kv_w_uk, kv_w_uv, cos, sin)
    return rmsnorm(h, final_norm)
```

```cpp
#include <hip/hip_runtime.h>
#include <hip/hip_cooperative_groups.h>
#include <cstdio>
#include <cstdint>
namespace cg = cooperative_groups;

#define LAS __attribute__((address_space(3)))
#define DI __device__ __forceinline__
typedef unsigned short bf16_t;
typedef short bf16x8 __attribute__((ext_vector_type(8)));
typedef float f32x4 __attribute__((ext_vector_type(4)));
typedef float f32x16 __attribute__((ext_vector_type(16)));
typedef unsigned u32x4 __attribute__((ext_vector_type(4)));
typedef unsigned u32x2 __attribute__((ext_vector_type(2)));
typedef __bf16 bf2_t __attribute__((ext_vector_type(2)));
typedef float f2_t __attribute__((ext_vector_type(2)));
typedef _Float16 h2_t __attribute__((ext_vector_type(2)));

constexpr int T_ = 32768;
constexpr int SEQ_ = 4096;
constexpr float EPS_ = 1e-6f;
constexpr size_t MiB = 1ull << 20;
constexpr size_t OFF_A = 0, OFF_B = 256 * MiB, OFF_C = 448 * MiB;
constexpr size_t OFF_HQ = OFF_A;
constexpr size_t OFF_HID0 = OFF_A;
constexpr size_t OFF_KN = OFF_A, OFF_VT = OFF_A + 128 * MiB;
constexpr size_t OFF_XB3 = OFF_A;
constexpr size_t OFF_HID1 = OFF_A + 64 * MiB;
constexpr size_t OFF_XB0 = OFF_B;
constexpr size_t OFF_OG = OFF_B + 64 * MiB;
constexpr size_t OFF_WHG = OFF_B + 128 * MiB;
constexpr size_t OFF_WWO = OFF_WHG + 8 * MiB;
constexpr size_t OFF_WUP0 = OFF_WWO + 2 * MiB;
constexpr size_t OFF_WDN0 = OFF_WUP0 + 8 * MiB;
constexpr size_t OFF_WDKVQ = OFF_WDN0 + 8 * MiB;
constexpr size_t OFF_Q = OFF_B;
constexpr size_t OFF_CKV = OFF_C, OFF_CQ = OFF_C + 16 * MiB, OFF_KR = OFF_C + 32 * MiB;
constexpr size_t OFF_WUKV = OFF_C + 36 * MiB;
constexpr size_t OFF_WUQ = OFF_WUKV + 2 * MiB;
constexpr size_t OFF_WMWO = OFF_WUQ + 3 * MiB / 2;
constexpr size_t OFF_WUP1 = OFF_WMWO + 4 * MiB;
constexpr size_t OFF_WDN1 = OFF_WUP1 + 8 * MiB;
constexpr size_t OFF_ROPE = OFF_WDN1 + 8 * MiB;
constexpr size_t OFF_SS = OFF_ROPE + 1 * MiB;
constexpr size_t OFF_LB = OFF_SS + 7 * (size_t)T_ * 4;
constexpr size_t WS_NEED = OFF_LB + 65536 + 16384;
constexpr size_t OFF_BAR = OFF_LB + 65536;
constexpr int LDS_BYTES = 131072 + 16;

struct Params {
    const float *x, *hgrn_norm, *w_q, *w_f, *w_i, *w_g, *g_norm, *w_o, *lb_logits, *mla_norm, *w_dq, *q_norm, *w_uq, *mla_w_o,
        *kv_in_norm, *w_dkv, *kv_norm, *w_uk, *w_uv, *mlp_norm, *w_up, *w_down, *final_norm;
    float* out;
    unsigned char* ws;
};

DI int phase_tid(int w) {
    asm volatile("" : "+s"(w));
    int l;
    asm volatile("v_mbcnt_lo_u32_b32 %0, -1, 0\n\tv_mbcnt_hi_u32_b32 %0, -1, %0" : "=v"(l));
    return w * 64 + l;
}
DI unsigned pk_bf16(float a, float b) { f2_t f = {a, b}; bf2_t h = __builtin_convertvector(f, bf2_t); return __builtin_bit_cast(unsigned, h); }
DI unsigned pk_f16(float a, float b) { f2_t f = {a, b}; h2_t h = __builtin_convertvector(f, h2_t); return __builtin_bit_cast(unsigned, h); }
DI bf16_t bf16_1(float a) { return (bf16_t)(pk_bf16(a, 0.f) & 0xffffu); }
DI float bf2f(unsigned short b) { return __uint_as_float((unsigned)b << 16); }
DI float fast_exp(float x) { return __builtin_amdgcn_exp2f(x * 1.4426950408889634f); }
DI float fast_rcp(float x) { return __builtin_amdgcn_rcpf(x); }
DI float sigmoidf_(float x) { return fast_rcp(1.0f + fast_exp(-x)); }

#define XB_TMO      128
#define XB_XCNT(j)  (256  + 64 * (j))
#define XB_XSUB(j)  (1280 + 64 * (j))
#define XB_XGEN(j)  (2304 + 64 * (j))
#define XB_TOP      3328
#define XB_TOPGEN   3392
#define XCD_BAR_WORDS 3456
#define XB_SPIN_CAP (1u << 18)

__device__ __forceinline__ unsigned xb_ld(unsigned* p)              { return __hip_atomic_load(p, __ATOMIC_RELAXED, __HIP_MEMORY_SCOPE_AGENT); }
__device__ __forceinline__ unsigned xb_add(unsigned* p, unsigned v) { return __hip_atomic_fetch_add(p, v, __ATOMIC_RELAXED, __HIP_MEMORY_SCOPE_AGENT); }
__device__ __forceinline__ unsigned xb_xcc_id() { return (unsigned)__builtin_amdgcn_s_getreg((3 << 11) | 20) & 0xFu; }
#define XB_SPIN(cond, bar) do { unsigned _sp = 0; while (cond) { __builtin_amdgcn_s_sleep(1); \
    if ((++_sp & 255u) == 0u) { if (xb_ld(&(bar)[XB_TMO])) break; if (_sp > XB_SPIN_CAP) { atomicAdd(&(bar)[XB_TMO], 1u); break; } } } } while (0)

struct XcdBarrier {
    unsigned* bar; unsigned x;
    volatile LAS unsigned* st;
};

__device__ __forceinline__ XcdBarrier xcd_barrier_post(unsigned* bar, volatile LAS unsigned* st, int tid) {
    XcdBarrier b; b.bar = bar; b.x = xb_xcc_id(); b.st = st;
    if (tid == 0) (void)xb_add(&bar[XB_XCNT(b.x)], 1u);
    return b;
}
__device__ __forceinline__ void xcd_barrier_complete(unsigned* bar, unsigned x, unsigned& nloc, unsigned& nx) {
    const unsigned G = gridDim.x * gridDim.y * gridDim.z;
    unsigned sum, cnt, mine, sp = 0u;
    for (;;) {
        sum = 0u; cnt = 0u; mine = 0u;
#pragma unroll
        for (unsigned j = 0; j < 16; ++j) { const unsigned c = xb_ld(&bar[XB_XCNT(j)]); sum += c; cnt += (c > 0u) ? 1u : 0u; mine = (j == x) ? c : mine; }
        if (sum == G) break;
        __builtin_amdgcn_s_sleep(1);
        if ((++sp & 255u) == 0u) { if (xb_ld(&bar[XB_TMO])) break; if (sp > XB_SPIN_CAP) { atomicAdd(&bar[XB_TMO], 1u); break; } }
    }
    nloc = mine > 0u ? mine : 1u; nx = cnt > 0u ? cnt : 1u;
}

__device__ __forceinline__ void xcd_barrier(const XcdBarrier& b, int tid) {
    asm volatile("s_waitcnt vmcnt(0)" ::: "memory");
    __syncthreads();
    if (tid == 0) {
        unsigned* bar = b.bar;
        __builtin_amdgcn_s_waitcnt(0);
        unsigned nloc = b.st[0], nx = b.st[1];
        if (nloc == 0u) { xcd_barrier_complete(bar, b.x, nloc, nx); b.st[0] = nloc; b.st[1] = nx; }
        const unsigned old = xb_add(&bar[XB_XSUB(b.x)], 1u);
        const unsigned gen = old / nloc;
        if (old + 1u == (gen + 1u) * nloc) {
            __builtin_amdgcn_fence(__ATOMIC_RELEASE, "agent");
            asm volatile("s_waitcnt vmcnt(0)" ::: "memory");
            const unsigned og = xb_add(&bar[XB_TOP], 1u);
            const unsigned tg = og / nx;
            if (og + 1u == (tg + 1u) * nx) xb_add(&bar[XB_TOPGEN], 1u);
            else XB_SPIN(xb_ld(&bar[XB_TOPGEN]) == tg, bar);
            __builtin_amdgcn_fence(__ATOMIC_ACQUIRE, "agent");
            xb_add(&bar[XB_XGEN(b.x)], 1u);
            asm volatile("s_waitcnt vmcnt(0)" ::: "memory");
        } else {
            XB_SPIN(xb_ld(&bar[XB_XGEN(b.x)]) == gen, bar);
            __builtin_amdgcn_fence(__ATOMIC_ACQUIRE, "agent");
            asm volatile("s_waitcnt vmcnt(0)" ::: "memory");
        }
    }
    __syncthreads();
}

namespace pg8 {
constexpr int BM = 256, BK = 64, HALF = 128, HTB = HALF * BK * 2, NXCD = 8, WGM = 8;
DI int lds_byte(int r, int c) { const int st = (r >> 4) * 2 + (c >> 5), rr = r & 15, cc = c & 31, ob = rr * 64 + cc * 2; return st * 1024 + (ob ^ (((ob >> 9) & 1) << 5)); }
DI void stage_rc(int b, int& R, int& C) { const int st = b / 1024, sb = b % 1024, swz = sb ^ (((sb >> 9) & 1) << 5); R = (st >> 1) * 16 + swz / 64; C = (st & 1) * 32 + (swz % 64) / 2; }
DI int perm32(int rho) { const int n = rho >> 4, i = rho & 15; return 8 * (i >> 2) + 4 * n + (i & 3); }
struct Unit { int pm, pn; };
struct Gemm { const bf16_t* A; const bf16_t* Bt; int M, N, K, lda, a2step, rev; };
struct StaticOrder {
    int nM, nN, nwg, G, c;
    int rev;
    DI void init(int M, int N, int G_, int c_, int rev_) { nM = M / BM; nN = N / BM; nwg = nM * nN; G = G_; c = c_; rev = rev_; }
    DI bool next(int i, Unit& u) const {
        const long L = (long)i * G + c; if (L >= nwg) return false;
        int wgid = (int)L; { const int q = nwg / NXCD, r = nwg % NXCD, xcd = wgid % NXCD, off = wgid / NXCD; wgid = (xcd < r ? xcd * (q + 1) : r * (q + 1) + (xcd - r) * q) + off; }
        const int nig = WGM * nN, gid = wgid / nig, fm = gid * WGM, gsz = (nM - fm) < WGM ? (nM - fm) : WGM;
        u.pm = fm + ((wgid % nig) % gsz); u.pn = (wgid % nig) / gsz; if (rev) u.pm = nM - 1 - u.pm; return true;
    }
};

template <class Epi>
DI void gemm_phase(int wave_id, LAS unsigned char* lds, const Gemm g, const Epi& E) {
    StaticOrder S; S.init(g.M, g.N, gridDim.x, blockIdx.x, g.rev);
    const int tid = phase_tid(wave_id),
              wid = __builtin_amdgcn_readfirstlane(tid >> 6), lane = tid & 63, wr = wid >> 2, wc = wid & 3, fr = lane & 15, fq = lane >> 4;
    const int K = g.K, nt = K / BK;
    unsigned voffA[2], voffB[2];
#pragma unroll
    for (int i = 0; i < 2; ++i) { int R, C; stage_rc(tid * 16 + i * 8192, R, C); const int Rb = (R & ~31) + perm32(R & 31); voffA[i] = (unsigned)(R * g.lda + C) * 2u; voffB[i] = (unsigned)(Rb * K + C) * 2u; }
    const size_t kstep = (size_t)(BK * 2);
    const size_t hstepA = (size_t)HALF * g.lda * 2, tstepA = 2 * hstepA;
    const size_t hstepB = (size_t)HALF * K * 2, tstepB = 2 * hstepB;
    const size_t a2 = (size_t)g.a2step;
    const unsigned ldsw = (unsigned)wid * 1024u;
    const int aoff = lds_byte(wr * 64 + fr, fq * 8), boff = lds_byte(wc * 32 + fr, fq * 8);
#define PG8_SA(b, h) (((b) * 2 + (h)) * HTB)
#define PG8_SB(b, h) ((4 + (b) * 2 + (h)) * HTB)
#define PG8_STAGE(bufoff, gbase, voff) do { _Pragma("unroll") for (int _i = 0; _i < 2; ++_i) \
        __builtin_amdgcn_global_load_lds((const unsigned*)((const char*)(gbase) + (voff)[_i]), (LAS unsigned*)(lds + (bufoff) + ldsw + _i * 8192), 16, 0, 0); } while (0)
#define PG8_LDA(dst, b, h) do { _Pragma("unroll") for (int m = 0; m < 4; ++m) _Pragma("unroll") for (int k = 0; k < 2; ++k) dst[m][k] = *(const LAS bf16x8*)(lds + PG8_SA(b, h) + aoff + m * 2048 + k * 1024); } while (0)
#define PG8_LDB(dst, b, h) do { _Pragma("unroll") for (int n = 0; n < 2; ++n) _Pragma("unroll") for (int k = 0; k < 2; ++k) dst[n][k] = *(const LAS bf16x8*)(lds + PG8_SB(b, h) + boff + n * 2048 + k * 1024); } while (0)
#define PG8_MMA(ai, bj, At, Bt) do { __builtin_amdgcn_s_setprio(1); _Pragma("unroll") for (int m = 0; m < 4; ++m) _Pragma("unroll") for (int n = 0; n < 2; ++n) _Pragma("unroll") for (int k = 0; k < 2; ++k) \
        acc[ai][bj][m][n] = __builtin_amdgcn_mfma_f32_16x16x32_bf16(Bt[n][k], At[m][k], acc[ai][bj][m][n], 0, 0, 0); __builtin_amdgcn_s_setprio(0); } while (0)
#define PG8_WAIT_V(n) asm volatile("s_waitcnt vmcnt(" #n ")" ::: "memory")
#define PG8_WAIT_L(n) asm volatile("s_waitcnt lgkmcnt(" #n ")" ::: "memory")
#define PG8_BAR __builtin_amdgcn_s_barrier()
#define PG8_SCHED __builtin_amdgcn_sched_barrier(0)
    Unit cur, nxt; int ui = 0;
    if (!S.next(0, cur)) return;
    f32x4 acc[2][2][4][2];
#pragma unroll
    for (int a = 0; a < 2; ++a)
#pragma unroll
        for (int b = 0; b < 2; ++b)
#pragma unroll
            for (int m = 0; m < 4; ++m)
#pragma unroll
                for (int n = 0; n < 2; ++n) acc[a][b][m][n] = (f32x4){0.f, 0.f, 0.f, 0.f};
    bf16x8 At[4][2], B0[2][2], B1[2][2];
    const char* cA = (const char*)g.A + (size_t)cur.pm * tstepA; const char* cB = (const char*)g.Bt + (size_t)cur.pn * tstepB;
    constexpr bool SP2 = true, ALIGN_EPI = true;
    if constexpr (SP2) {
        PG8_STAGE(PG8_SB(0, 0), cB, voffB); PG8_STAGE(PG8_SB(0, 1), cB + hstepB, voffB); PG8_STAGE(PG8_SA(0, 0), cA, voffA); PG8_STAGE(PG8_SA(0, 1), cA + hstepA, voffA);
        if (wr == 1) PG8_BAR;
        PG8_WAIT_V(2); PG8_BAR;
        PG8_STAGE(PG8_SB(1, 0), cB + kstep, voffB); PG8_STAGE(PG8_SA(1, 0), cA + kstep, voffA); PG8_STAGE(PG8_SB(1, 1), cB + hstepB + kstep, voffB);
        PG8_WAIT_V(6); PG8_BAR;
    } else {
    PG8_STAGE(PG8_SB(0, 0), cB, voffB); PG8_STAGE(PG8_SA(0, 0), cA, voffA); PG8_STAGE(PG8_SB(0, 1), cB + hstepB, voffB); PG8_STAGE(PG8_SA(0, 1), cA + hstepA, voffA);
    if (wr == 1) PG8_BAR;
    PG8_WAIT_V(4); PG8_BAR;
    PG8_STAGE(PG8_SB(1, 0), cB + kstep, voffB); PG8_STAGE(PG8_SA(1, 0), cA + kstep, voffA); PG8_STAGE(PG8_SB(1, 1), cB + hstepB + kstep, voffB);
    PG8_WAIT_V(6); PG8_BAR;
    }
    for (;;) {
        const bool has_next = S.next(ui + 1, nxt);
        const char* nA = has_next ? (const char*)g.A + (size_t)nxt.pm * tstepA : cA; const char* nB = has_next ? (const char*)g.Bt + (size_t)nxt.pn * tstepB : cB;
        for (int t = 0; t < nt; t += 2) {
            const bool last = (t == nt - 2);
            const char* a1 = cA + (size_t)(t >> 1) * a2 + kstep;
            const char* a2p = last ? nA : cA + (size_t)((t >> 1) + 1) * a2; const char* b2 = last ? nB : cB + (size_t)(t + 2) * kstep;
            const char* a3 = a2p + kstep; const char* b3 = b2 + kstep;
            if constexpr (SP2) {
            PG8_LDB(B0, 0, 0); PG8_LDB(B1, 0, 1); PG8_SCHED; PG8_LDA(At, 0, 0); PG8_STAGE(PG8_SA(1, 1), a1 + hstepA, voffA);
            PG8_WAIT_V(8); PG8_WAIT_L(0); PG8_BAR; PG8_MMA(0, 0, At, B0); PG8_MMA(0, 1, At, B1); PG8_BAR; PG8_SCHED;
            PG8_LDA(At, 0, 1); PG8_STAGE(PG8_SB(0, 0), b2, voffB); PG8_STAGE(PG8_SB(0, 1), b2 + hstepB, voffB); PG8_STAGE(PG8_SA(0, 0), a2p, voffA);
            PG8_WAIT_V(8); PG8_WAIT_L(0); PG8_BAR; PG8_MMA(1, 0, At, B0); PG8_MMA(1, 1, At, B1); PG8_BAR; PG8_SCHED;
            PG8_LDB(B0, 1, 0); PG8_LDB(B1, 1, 1); PG8_SCHED; PG8_LDA(At, 1, 0); PG8_STAGE(PG8_SA(0, 1), a2p + hstepA, voffA);
            PG8_WAIT_V(8); PG8_WAIT_L(0); PG8_BAR; PG8_MMA(0, 0, At, B0); PG8_MMA(0, 1, At, B1); PG8_BAR; PG8_SCHED;
            PG8_LDA(At, 1, 1); PG8_STAGE(PG8_SB(1, 0), b3, voffB); PG8_STAGE(PG8_SB(1, 1), b3 + hstepB, voffB); PG8_STAGE(PG8_SA(1, 0), a3, voffA);
            PG8_WAIT_V(8); PG8_WAIT_L(0); PG8_BAR; PG8_MMA(1, 0, At, B0); PG8_MMA(1, 1, At, B1); PG8_BAR; PG8_SCHED;
            } else {
            PG8_LDB(B0, 0, 0); PG8_SCHED; PG8_LDA(At, 0, 0); PG8_STAGE(PG8_SA(1, 1), a1 + hstepA, voffA);
            PG8_WAIT_L(8); PG8_BAR; PG8_WAIT_L(0); PG8_MMA(0, 0, At, B0); PG8_BAR; PG8_SCHED;
            PG8_LDB(B1, 0, 1); PG8_STAGE(PG8_SB(0, 0), b2, voffB);
            PG8_BAR; PG8_WAIT_L(0); PG8_MMA(0, 1, At, B1); PG8_BAR;
            PG8_LDA(At, 0, 1); PG8_STAGE(PG8_SA(0, 0), a2p, voffA);
            PG8_BAR; PG8_WAIT_L(0); PG8_MMA(1, 0, At, B0); PG8_BAR; PG8_SCHED;
            PG8_STAGE(PG8_SB(0, 1), b2 + hstepB, voffB);
            PG8_WAIT_V(6); PG8_BAR; PG8_MMA(1, 1, At, B1); PG8_BAR;
            PG8_LDB(B0, 1, 0); PG8_SCHED; PG8_LDA(At, 1, 0); PG8_STAGE(PG8_SA(0, 1), a2p + hstepA, voffA);
            PG8_WAIT_L(8); PG8_BAR; PG8_WAIT_L(0); PG8_MMA(0, 0, At, B0); PG8_BAR; PG8_SCHED;
            PG8_LDB(B1, 1, 1); PG8_STAGE(PG8_SB(1, 0), b3, voffB);
            PG8_BAR; PG8_WAIT_L(0); PG8_MMA(0, 1, At, B1); PG8_BAR;
            PG8_LDA(At, 1, 1); PG8_STAGE(PG8_SA(1, 0), a3, voffA);
            PG8_BAR; PG8_WAIT_L(0); PG8_MMA(1, 0, At, B0); PG8_BAR; PG8_SCHED;
            PG8_STAGE(PG8_SB(1, 1), b3 + hstepB, voffB);
            PG8_WAIT_V(6); PG8_BAR; PG8_MMA(1, 1, At, B1); PG8_BAR;
            }
        }
        if constexpr (ALIGN_EPI) { if (wr == 0) PG8_BAR; }
        E(acc, cur, wr, wc, fr, fq);
        if (!has_next) break;
#pragma unroll
        for (int a = 0; a < 2; ++a)
#pragma unroll
            for (int b = 0; b < 2; ++b)
#pragma unroll
                for (int m = 0; m < 4; ++m)
#pragma unroll
                    for (int n = 0; n < 2; ++n) acc[a][b][m][n] = (f32x4){0.f, 0.f, 0.f, 0.f};
        cur = nxt; cA = nA; cB = nB; ++ui;
        if constexpr (ALIGN_EPI) { if (wr == 1) PG8_BAR; }
    }
    PG8_WAIT_V(0);
    if constexpr (!ALIGN_EPI) { if (wr == 0) PG8_BAR; }
    PG8_BAR;
#undef PG8_SA
#undef PG8_SB
#undef PG8_STAGE
#undef PG8_LDA
#undef PG8_LDB
#undef PG8_MMA
}

typedef const f32x4 (&AccRef)[2][2][4][2];
DI u32x4 pk8(const f32x4 a, const f32x4 b) { return (u32x4){pk_bf16(a[0], a[1]), pk_bf16(a[2], a[3]), pk_bf16(b[0], b[1]), pk_bf16(b[2], b[3])}; }
DI void rope4(f32x4& a, f32x4& b, const f2_t* rp) {
    const f32x4 c01 = *(const f32x4*)rp, c23 = *(const f32x4*)(rp + 2);
    const f32x4 oa = {a[0] * c01[0] - a[1] * c01[1], a[1] * c01[0] + a[0] * c01[1], a[2] * c01[2] - a[3] * c01[3], a[3] * c01[2] + a[2] * c01[3]};
    const f32x4 ob = {b[0] * c23[0] - b[1] * c23[1], b[1] * c23[0] + b[0] * c23[1], b[2] * c23[2] - b[3] * c23[3], b[3] * c23[2] + b[2] * c23[3]};
    a = oa; b = ob;
}

struct EpiHG {
    const float* ss; const float* lb; bf16_t* out;
    DI void operator()(AccRef acc, const Unit& u, int wr, int wc, int fr, int fq) const {
        const int type = u.pn >> 2;
        const int cbase = (u.pn & 3) * 256 + wc * 32 + 8 * fq;
        bf16_t* o = out + (size_t)(type == 2 ? 3 : type) * T_ * 1024;
#pragma unroll
        for (int ai = 0; ai < 2; ++ai)
#pragma unroll
            for (int m = 0; m < 4; ++m) {
                const int row = u.pm * 256 + ai * 128 + wr * 64 + m * 16 + fr;
                const float rs = rsqrtf(ss[row] * (1.0f / 1024.0f) + EPS_);
#pragma unroll
                for (int bj = 0; bj < 2; ++bj) {
                    const int col = cbase + bj * 128;
                    f32x4 v0 = acc[ai][bj][m][0] * rs, v1 = acc[ai][bj][m][1] * rs;
                    u32x4 w;
                    if (type != 1) {
#pragma unroll
                        for (int j = 0; j < 4; ++j) { v0[j] = v0[j] * sigmoidf_(v0[j]); v1[j] = v1[j] * sigmoidf_(v1[j]); }
                        w = pk8(v0, v1);
                    } else {
                        const f32x4 l0 = *(const f32x4*)(lb + col), l1 = *(const f32x4*)(lb + col + 4);
#pragma unroll
                        for (int j = 0; j < 4; ++j) { v0[j] = __logf(l0[j] + (1.0f - l0[j]) * sigmoidf_(v0[j])); v1[j] = __logf(l1[j] + (1.0f - l1[j]) * sigmoidf_(v1[j])); }
                        w = (u32x4){pk_f16(v0[0], v0[1]), pk_f16(v0[2], v0[3]), pk_f16(v1[0], v1[1]), pk_f16(v1[2], v1[3])};
                    }
                    *(u32x4*)(o + (size_t)row * 1024 + col) = w;
                }
            }
    }
};

struct EpiHVT {
    const float* ss; bf16_t* out;
    DI void operator()(AccRef acc, const Unit& u, int wr, int wc, int fr, int fq) const {
        const int cbase = u.pn * 256 + wc * 32 + 8 * fq;
#pragma unroll
        for (int bj = 0; bj < 2; ++bj) {
            const int tok = cbase + bj * 128;
            const f32x4 sa = *(const f32x4*)(ss + tok), sb = *(const f32x4*)(ss + tok + 4);
            f32x4 r0, r1;
#pragma unroll
            for (int j = 0; j < 4; ++j) { r0[j] = rsqrtf(sa[j] * (1.0f / 1024.0f) + EPS_); r1[j] = rsqrtf(sb[j] * (1.0f / 1024.0f) + EPS_); }
            const int bc = tok >> 6, s = tok & 63;
#pragma unroll
            for (int ai = 0; ai < 2; ++ai)
#pragma unroll
                for (int m = 0; m < 4; ++m) {
                    const int hv = u.pm * 256 + ai * 128 + wr * 64 + m * 16 + fr;
                    *(u32x4*)(out + ((size_t)(bc * 8 + (hv >> 7)) * 128 + (hv & 127)) * 64 + s) = pk8(acc[ai][bj][m][0] * r0, acc[ai][bj][m][1] * r1);
                }
        }
    }
};

template <bool RES_F32>
struct EpiRes {
    const void* res; bf16_t* xb; float* ss;
    DI void operator()(AccRef acc, const Unit& u, int wr, int wc, int fr, int fq) const {
        const int cbase = u.pn * 256 + wc * 32 + 8 * fq;
#pragma unroll
        for (int ai = 0; ai < 2; ++ai)
#pragma unroll
            for (int m = 0; m < 4; ++m) {
                const int row = u.pm * 256 + ai * 128 + wr * 64 + m * 16 + fr;
                float sq = 0.f;
#pragma unroll
                for (int bj = 0; bj < 2; ++bj) {
                    const size_t off = (size_t)row * 1024 + cbase + bj * 128;
                    f32x4 r0, r1;
                    if (RES_F32) { r0 = *(const f32x4*)((const float*)res + off); r1 = *(const f32x4*)((const float*)res + off + 4); }
                    else { const u32x4 rb = *(const u32x4*)((const bf16_t*)res + off);
                        r0 = (f32x4){__uint_as_float(rb.x << 16), __uint_as_float(rb.x & 0xffff0000u), __uint_as_float(rb.y << 16), __uint_as_float(rb.y & 0xffff0000u)};
                        r1 = (f32x4){__uint_as_float(rb.z << 16), __uint_as_float(rb.z & 0xffff0000u), __uint_as_float(rb.w << 16), __uint_as_float(rb.w & 0xffff0000u)}; }
                    const f32x4 v0 = acc[ai][bj][m][0] + r0, v1 = acc[ai][bj][m][1] + r1;
                    *(u32x4*)(xb + off) = pk8(v0, v1);
                    sq += ((v0[0] * v0[0] + v0[1] * v0[1]) + (v0[2] * v0[2] + v0[3] * v0[3])) + ((v1[0] * v1[0] + v1[1] * v1[1]) + (v1[2] * v1[2] + v1[3] * v1[3]));
                }
                sq += __shfl_xor(sq, 16); sq += __shfl_xor(sq, 32);
                if (fq == 0) unsafeAtomicAdd(ss + row, sq);
            }
    }
};

struct EpiRelu2 {
    const float* ss; bf16_t* out;
    DI void operator()(AccRef acc, const Unit& u, int wr, int wc, int fr, int fq) const {
        const int cbase = u.pn * 256 + wc * 32 + 8 * fq;
#pragma unroll
        for (int ai = 0; ai < 2; ++ai)
#pragma unroll
            for (int m = 0; m < 4; ++m) {
                const int row = u.pm * 256 + ai * 128 + wr * 64 + m * 16 + fr;
                const float rs = rsqrtf(ss[row] * (1.0f / 1024.0f) + EPS_);
#pragma unroll
                for (int bj = 0; bj < 2; ++bj) {
                    f32x4 v0 = acc[ai][bj][m][0] * rs, v1 = acc[ai][bj][m][1] * rs;
#pragma unroll
                    for (int j = 0; j < 4; ++j) { const float t0 = fmaxf(v0[j], 0.f), t1 = fmaxf(v1[j], 0.f); v0[j] = t0 * t0; v1[j] = t1 * t1; }
                    *(u32x4*)(out + (size_t)row * 4096 + cbase + bj * 128) = pk8(v0, v1);
                }
            }
    }
};

struct EpiDKVQ {
    const float* ss; bf16_t* ckv; bf16_t* cq; bf16_t* kr; float* ss_ckv; float* ss_cq; const f2_t* rope;
    DI void operator()(AccRef acc, const Unit& u, int wr, int wc, int fr, int fq) const {
#pragma unroll
        for (int ai = 0; ai < 2; ++ai)
#pragma unroll
            for (int m = 0; m < 4; ++m) {
                const int row = u.pm * 256 + ai * 128 + wr * 64 + m * 16 + fr;
                const float rs = rsqrtf(ss[row] * (1.0f / 1024.0f) + EPS_);
                if (u.pn < 2) {
                    bf16_t* dst = u.pn ? cq : ckv; float* sd = u.pn ? ss_cq : ss_ckv;
                    float sq = 0.f;
#pragma unroll
                    for (int bj = 0; bj < 2; ++bj) {
                        const int col = bj * 128 + wc * 32 + 8 * fq;
                        const f32x4 v0 = acc[ai][bj][m][0] * rs, v1 = acc[ai][bj][m][1] * rs;
                        *(u32x4*)(dst + (size_t)row * 256 + col) = pk8(v0, v1);
                        sq += ((v0[0] * v0[0] + v0[1] * v0[1]) + (v0[2] * v0[2] + v0[3] * v0[3])) + ((v1[0] * v1[0] + v1[1] * v1[1]) + (v1[2] * v1[2] + v1[3] * v1[3]));
                    }
                    sq += __shfl_xor(sq, 16); sq += __shfl_xor(sq, 32);
                    if (fq == 0) unsafeAtomicAdd(sd + row, sq);
                } else if (wc < 2) {
                    const int pos = row & (SEQ_ - 1);
                    const int col = wc * 32 + 8 * fq;
                    f32x4 v0 = acc[ai][0][m][0] * rs, v1 = acc[ai][0][m][1] * rs;
                    rope4(v0, v1, rope + pos * 32 + (col >> 1));
                    *(u32x4*)(kr + (size_t)row * 64 + col) = pk8(v0, v1);
                }
            }
    }
};

struct EpiKN {
    const float* ss; bf16_t* out;
    DI void operator()(AccRef acc, const Unit& u, int wr, int wc, int fr, int fq) const {
        const int cbase = u.pn * 256 + wc * 32 + 8 * fq;
#pragma unroll
        for (int ai = 0; ai < 2; ++ai)
#pragma unroll
            for (int m = 0; m < 4; ++m) {
                const int row = u.pm * 256 + ai * 128 + wr * 64 + m * 16 + fr;
                const float rs = rsqrtf(ss[row] * (1.0f / 256.0f) + EPS_);
#pragma unroll
                for (int bj = 0; bj < 2; ++bj)
                    *(u32x4*)(out + (size_t)row * 2048 + cbase + bj * 128) = pk8(acc[ai][bj][m][0] * rs, acc[ai][bj][m][1] * rs);
            }
    }
};

struct EpiVT {
    const float* ss; bf16_t* out;
    DI void operator()(AccRef acc, const Unit& u, int wr, int wc, int fr, int fq) const {
        const int cbase = u.pn * 256 + wc * 32 + 8 * fq;
#pragma unroll
        for (int bj = 0; bj < 2; ++bj)
#pragma unroll
            for (int n = 0; n < 2; ++n) {
                const int tok = cbase + bj * 128 + 4 * n;
                const f32x4 s4 = *(const f32x4*)(ss + tok);
                f32x4 rs;
#pragma unroll
                for (int j = 0; j < 4; ++j) rs[j] = rsqrtf(s4[j] * (1.0f / 256.0f) + EPS_);
                const int b = tok >> 12, s = tok & (SEQ_ - 1);
                const int ps = (s & ~12) | ((s & 4) << 1) | ((s & 8) >> 1);
#pragma unroll
                for (int ai = 0; ai < 2; ++ai)
#pragma unroll
                    for (int m = 0; m < 4; ++m) {
                        const int hv = u.pm * 256 + ai * 128 + wr * 64 + m * 16 + fr;
                        const f32x4 v = acc[ai][bj][m][n] * rs;
                        u32x2 w; w.x = pk_bf16(v[0], v[1]); w.y = pk_bf16(v[2], v[3]);
                        *(u32x2*)(out + ((size_t)(b * 2048 + hv) * SEQ_ + ps)) = w;
                    }
            }
    }
};

struct EpiQ {
    const float* ss; bf16_t* out; const f2_t* rope;
    DI void operator()(AccRef acc, const Unit& u, int wr, int wc, int fr, int fq) const {
        const int cbase = u.pn * 256 + wc * 32 + 8 * fq;
        const float QS = 0.07216878364870322f * 1.4426950408889634f;
#pragma unroll
        for (int ai = 0; ai < 2; ++ai)
#pragma unroll
            for (int m = 0; m < 4; ++m) {
                const int row = u.pm * 256 + ai * 128 + wr * 64 + m * 16 + fr;
                const float rs = rsqrtf(ss[row] * (1.0f / 256.0f) + EPS_) * QS;
                const int pos = row & (SEQ_ - 1);
#pragma unroll
                for (int bj = 0; bj < 2; ++bj) {
                    const int col = cbase + bj * 128;
                    const int d = col % 192;
                    f32x4 v0 = acc[ai][bj][m][0] * rs, v1 = acc[ai][bj][m][1] * rs;
                    if (d >= 128) rope4(v0, v1, rope + pos * 32 + ((d - 128) >> 1));
                    *(u32x4*)(out + (size_t)row * 3072 + col) = pk8(v0, v1);
                }
            }
    }
};
}

struct WJob { const float* W; const float* gain; bf16_t* dst; int ldw, coloff, K, N, ldd, mode, rowoff; };
DI int wjob_row(const WJob& j, int n) {
    if (j.mode == 0) return j.rowoff + n;
    if (j.mode == 1) return j.rowoff + ((n < 32) ? 2 * n : 2 * (n - 32) + 1);
    const int hh = n / 192, d = n - hh * 192;
    if (d < 128) return n;
    const int r = d - 128;
    return hh * 192 + 128 + ((r < 32) ? 2 * r : 2 * (r - 32) + 1);
}
DI WJob get_job(const Params& p, int j) {
    unsigned char* ws = p.ws;
    bf16_t* HG = (bf16_t*)(ws + OFF_WHG); bf16_t* DKVQ = (bf16_t*)(ws + OFF_WDKVQ); bf16_t* UKV = (bf16_t*)(ws + OFF_WUKV);
    switch (j) {
        case 0: return WJob{p.w_q, p.hgrn_norm, HG, 1024, 0, 1024, 1024, 1024, 0, 0};
        case 1: return WJob{p.w_f, p.hgrn_norm, HG, 1024, 0, 1024, 1024, 1024, 0, 1024};
        case 2: return WJob{p.w_i, p.hgrn_norm, HG, 1024, 0, 1024, 1024, 1024, 0, 3072};
        case 3: return WJob{p.w_g, p.hgrn_norm, HG, 1024, 0, 1024, 1024, 1024, 0, 2048};
        case 4: return WJob{p.w_o, nullptr, (bf16_t*)(ws + OFF_WWO), 1024, 0, 1024, 1024, 1024, 0, 0};
        case 5: return WJob{p.w_up, p.mlp_norm, (bf16_t*)(ws + OFF_WUP0), 4096, 0, 1024, 4096, 1024, 0, 0};
        case 6: return WJob{p.w_down, nullptr, (bf16_t*)(ws + OFF_WDN0), 1024, 0, 4096, 1024, 4096, 0, 0};
        case 7: return WJob{p.w_dkv, p.kv_in_norm, DKVQ, 320, 0, 1024, 256, 1024, 0, 0};
        case 8: return WJob{p.w_dkv, p.kv_in_norm, DKVQ, 320, 256, 1024, 64, 1024, 1, 512};
        case 9: return WJob{p.w_dq, p.mla_norm, DKVQ, 256, 0, 1024, 256, 1024, 0, 256};
        case 10: return WJob{p.w_uk, p.kv_norm, UKV, 2048, 0, 256, 2048, 256, 0, 0};
        case 11: return WJob{p.w_uv, p.kv_norm, UKV, 2048, 0, 256, 2048, 256, 0, 2048};
        case 12: return WJob{p.w_uq, p.q_norm, (bf16_t*)(ws + OFF_WUQ), 3072, 0, 256, 3072, 256, 2, 0};
        case 13: return WJob{p.mla_w_o, nullptr, (bf16_t*)(ws + OFF_WMWO), 1024, 0, 2048, 1024, 2048, 0, 0};
        case 14: return WJob{p.w_up + (size_t)1024 * 4096, p.mlp_norm + 1024, (bf16_t*)(ws + OFF_WUP1), 4096, 0, 1024, 4096, 1024, 0, 0};
        default: return WJob{p.w_down + (size_t)4096 * 1024, nullptr, (bf16_t*)(ws + OFF_WDN1), 1024, 0, 4096, 1024, 4096, 0, 0};
    }
}

DI void prologue_phase(int wave_id, const Params& p, LAS unsigned char* lds) {
    const int tid = phase_tid(wave_id), lane = tid & 63, wid = tid >> 6;
    const int G = gridDim.x, c = blockIdx.x;
    unsigned char* ws = p.ws;
    {
        LAS float* tileA = (LAS float*)lds;
        LAS float* tileB = (LAS float*)(lds + 16640);
        const int tx = tid & 63, ty = tid >> 6;
        constexpr int total = 6480;
        float regA[8], regB[8];
        WJob ja = get_job(p, 0), jb2 = get_job(p, 0); int ak0 = 0, an0 = 0, bk0 = 0, bn0 = 0;
#define WDECODE(g_, jb_, k0_, n0_) do { const int gg_ = (g_); \
            const int j_ = gg_ >= 5456 ? 15 : gg_ >= 4432 ? 14 : gg_ >= 3920 ? 13 : gg_ >= 3728 ? 12 : gg_ >= 3600 ? 11 : gg_ >= 3472 ? 10 : gg_ >= 3408 ? 9 : gg_ >= 3392 ? 8 : gg_ >= 3328 ? 7 : gg_ >= 2304 ? 6 : gg_ >= 1280 ? 5 : (gg_ >> 8); \
            const int base_ = gg_ >= 5456 ? 5456 : gg_ >= 4432 ? 4432 : gg_ >= 3920 ? 3920 : gg_ >= 3728 ? 3728 : gg_ >= 3600 ? 3600 : gg_ >= 3472 ? 3472 : gg_ >= 3408 ? 3408 : gg_ >= 3392 ? 3392 : gg_ >= 3328 ? 3328 : gg_ >= 2304 ? 2304 : gg_ >= 1280 ? 1280 : ((gg_ >> 8) << 8); \
            jb_ = get_job(p, j_); const int t_ = gg_ - base_; const int tn_ = jb_.N / 64; k0_ = (t_ / tn_) * 64; n0_ = (t_ % tn_) * 64; } while (0)
#define WLOAD(reg_, jb_, k0_, n0_) do { _Pragma("unroll") for (int i = 0; i < 8; ++i) { const int k = ty + 8 * i; \
            reg_[i] = jb_.W[(size_t)(k0_ + k) * jb_.ldw + jb_.coloff + n0_ + tx]; } } while (0)
#define WSTORE(tile_, oj_, ok0_, on0_, gv_) do { _Pragma("unroll") for (int i = 0; i < 8; ++i) { const int n = ty + 8 * i; \
            oj_.dst[(size_t)wjob_row(oj_, on0_ + n) * oj_.ldd + ok0_ + tx] = bf16_1(tile_[tx * 65 + n] * gv_); } } while (0)
        int g = c;
        bool haveA = g < total, haveB = g + G < total;
        if (haveA) { WDECODE(g, ja, ak0, an0); WLOAD(regA, ja, ak0, an0); }
        if (haveB) { WDECODE(g + G, jb2, bk0, bn0); WLOAD(regB, jb2, bk0, bn0); }
        while (haveA) {
#pragma unroll
            for (int i = 0; i < 8; ++i) { tileA[(ty + 8 * i) * 65 + tx] = regA[i]; if (haveB) tileB[(ty + 8 * i) * 65 + tx] = regB[i]; }
            __syncthreads();
            const WJob oa = ja, ob = jb2; const int oak0 = ak0, oan0 = an0, obk0 = bk0, obn0 = bn0; const bool hadB = haveB;
            const float gva = oa.gain ? oa.gain[oak0 + tx] : 1.0f;
            const float gvb = (hadB && ob.gain) ? ob.gain[obk0 + tx] : 1.0f;
            g += 2 * G;
            haveA = g < total; haveB = g + G < total;
            if (haveA) { WDECODE(g, ja, ak0, an0); WLOAD(regA, ja, ak0, an0); }
            if (haveB) { WDECODE(g + G, jb2, bk0, bn0); WLOAD(regB, jb2, bk0, bn0); }
            WSTORE(tileA, oa, oak0, oan0, gva);
            if (hadB) WSTORE(tileB, ob, obk0, obn0, gvb);
            __syncthreads();
        }
#undef WDECODE
#undef WLOAD
#undef WSTORE
    }
    {
        bf16_t* xb = (bf16_t*)(ws + OFF_XB0); float* ssx = (float*)(ws + OFF_SS);
        for (int row = (c * 8 + wid) * 4; row < T_; row += G * 8 * 4) {
            f32x4 v[4][4];
#pragma unroll
            for (int rr = 0; rr < 4; ++rr)
#pragma unroll
                for (int i = 0; i < 4; ++i) v[rr][i] = *((const f32x4*)(p.x + (size_t)(row + rr) * 1024) + lane + 64 * i);
#pragma unroll
            for (int rr = 0; rr < 4; ++rr) {
                float sq = 0.f;
#pragma unroll
                for (int i = 0; i < 4; ++i) {
                    const f32x4 t = v[rr][i];
                    sq += (t[0] * t[0] + t[1] * t[1]) + (t[2] * t[2] + t[3] * t[3]);
                    u32x2 w; w.x = pk_bf16(t[0], t[1]); w.y = pk_bf16(t[2], t[3]);
                    *(u32x2*)(xb + (size_t)(row + rr) * 1024 + (lane + 64 * i) * 4) = w;
                }
#pragma unroll
                for (int o = 32; o >= 1; o >>= 1) sq += __shfl_xor(sq, o);
                if (lane == 0) ssx[row + rr] = sq;
            }
        }
    }
    {
        float* ss = (float*)(ws + OFF_SS) + T_;
        for (int i = c * 512 + tid; i < 6 * T_; i += G * 512) ss[i] = 0.f;
        u32x4* pad = (u32x4*)(ws + OFF_WDKVQ + (size_t)576 * 1024 * 2);
        for (int i = c * 512 + tid; i < 192 * 1024 * 2 / 16; i += G * 512) pad[i] = (u32x4){0u, 0u, 0u, 0u};
    }
    {
        f2_t* rope = (f2_t*)(ws + OFF_ROPE);
        for (int i = c * 512 + tid; i < SEQ_ * 32; i += G * 512) {
            const int pos = i >> 5, k = i & 31;
            const float invf = exp2f(-(float)k * (13.287712379549449f / 32.0f));
            const float ang = (float)pos * invf;
            double t = (double)ang * 0.15915494309189535;
            t -= __builtin_floor(t);
            const float fr = (float)t;
            rope[i] = (f2_t){__builtin_amdgcn_cosf(fr), __builtin_amdgcn_sinf(fr)};
        }
        float* lb = (float*)(ws + OFF_LB);
        for (int i = c * 512 + tid; i < 1024; i += G * 512) lb[i] = sigmoidf_(p.lb_logits[i] - p.lb_logits[1024 + i]);
    }
}

DI f32x4 mfma16(bf16x8 a, bf16x8 b, f32x4 c) { return __builtin_amdgcn_mfma_f32_16x16x32_bf16(a, b, c, 0, 0, 0); }
DI f32x16 mfma32(bf16x8 a, bf16x8 b, f32x16 c) { return __builtin_amdgcn_mfma_f32_32x32x16_bf16(a, b, c, 0, 0, 0); }

constexpr size_t OFF_SEND = OFF_B + 156 * MiB;
constexpr size_t OFF_DSEG = OFF_B + 172 * MiB;
DI void hgrn_phase1(int wave_id, const Params& p, LAS unsigned char* lds) {
    constexpr int QT = 0, KH = 17408, OB = 0, KT = 34816, VT = 53248, ST = 71680, PM = 106496, SEG = 115712, DEC = 119808;
    const int tid = phase_tid(wave_id), lane = tid & 63, wid = __builtin_amdgcn_readfirstlane(tid >> 6), fr = lane & 15, fq = lane >> 4;
    bf16_t* HQ = (bf16_t*)(p.ws + OFF_HQ);
    const bf16_t* HGl = (const bf16_t*)(p.ws + OFF_HQ + 64 * MiB);
    const bf16_t* HVt = (const bf16_t*)(p.ws + OFF_HQ + 128 * MiB);
    bf16_t* OL = (bf16_t*)p.out;
    const int dp = lane, seg = wid;
    for (int unit = blockIdx.x; unit < 256; unit += gridDim.x) {
        const int b = unit >> 5, h = (unit >> 2) & 7, sg = unit & 3, c0 = sg * 16;
        f32x4 Sacc[8];
#pragma unroll
        for (int i = 0; i < 8; ++i) Sacc[i] = (f32x4){0.f, 0.f, 0.f, 0.f};
        for (int i = tid; i < 34816 / 16; i += 512) *(LAS u32x4*)(lds + ST + i * 16) = (u32x4){0u, 0u, 0u, 0u};
        float cum0 = 0.f, cum1 = 0.f;
        unsigned q2[8], g2[8]; u32x4 vv[2];
#define HG_LOAD(c_) do { const size_t r0_ = (size_t)b * SEQ_ + (size_t)(c_) * 64; \
            _Pragma("unroll") for (int tt = 0; tt < 8; ++tt) { const size_t idx = (r0_ + seg * 8 + tt) * 1024 + h * 128 + 2 * dp; \
                q2[tt] = *(const unsigned*)(HQ + idx); g2[tt] = *(const unsigned*)(HGl + idx); } \
            const bf16_t* vb_ = HVt + ((size_t)((b * 64 + (c_)) * 8 + h)) * 8192; \
            vv[0] = *(const u32x4*)(vb_ + tid * 8); vv[1] = *(const u32x4*)(vb_ + 4096 + tid * 8); } while (0)
        HG_LOAD(c0);
        __syncthreads();
        for (int c = c0; c < c0 + 16; ++c) {
            const size_t row0 = (size_t)b * SEQ_ + (size_t)c * 64;
            float g[8][2], q[8][2], kk[8][2];
            float run0 = 0.f, run1 = 0.f;
#pragma unroll
            for (int tt = 0; tt < 8; ++tt) {
                const h2_t gh = __builtin_bit_cast(h2_t, g2[tt]);
                const float g0 = (float)gh[0], g1 = (float)gh[1];
                q[tt][0] = __uint_as_float(q2[tt] << 16); q[tt][1] = __uint_as_float(q2[tt] & 0xffff0000u);
                kk[tt][0] = 1.0f - fast_exp(g0); kk[tt][1] = 1.0f - fast_exp(g1);
                run0 += g0; run1 += g1; g[tt][0] = run0; g[tt][1] = run1;
            }
            *(LAS u32x4*)(lds + VT + ((tid >> 3) * 72 + (tid & 7) * 8) * 2) = vv[0];
            *(LAS u32x4*)(lds + VT + ((64 + (tid >> 3)) * 72 + (tid & 7) * 8) * 2) = vv[1];
            *(LAS f2_t*)(lds + SEG + (seg * 128 + 2 * dp) * 4) = (f2_t){run0, run1};
            __syncthreads();
            float off0 = 0.f, off1 = 0.f, tot0 = 0.f, tot1 = 0.f;
#pragma unroll
            for (int s8 = 0; s8 < 8; ++s8) { const f2_t xx = *(const LAS f2_t*)(lds + SEG + (s8 * 128 + 2 * dp) * 4); if (s8 < seg) { off0 += xx.x; off1 += xx.y; } tot0 += xx.x; tot1 += xx.y; }
            if (seg == 0) *(LAS f2_t*)(lds + DEC + 2 * dp * 4) = (f2_t){fast_exp(tot0), fast_exp(tot1)};
            const float ec0 = fast_exp(cum0), ec1 = fast_exp(cum1);
            float kt0[8], kt1[8];
#pragma unroll
            for (int tt = 0; tt < 8; ++tt) {
                const float b0 = off0 + g[tt][0], b1 = off1 + g[tt][1];
                const int t = seg * 8 + tt;
                const float qa = q[tt][0] * fast_exp(b0), qb_ = q[tt][1] * fast_exp(b1);
                *(LAS unsigned*)(lds + QT + (t * 136 + 2 * dp) * 2) = pk_bf16(qa, qb_);
                if (sg > 0) *(unsigned*)(HQ + (row0 + t) * 1024 + h * 128 + 2 * dp) = pk_bf16(qa * ec0, qb_ * ec1);
                *(LAS unsigned*)(lds + KH + (t * 136 + 2 * dp) * 2) = pk_bf16(kk[tt][0] * fast_exp(-b0), kk[tt][1] * fast_exp(-b1));
                kt0[tt] = kk[tt][0] * fast_exp(tot0 - b0); kt1[tt] = kk[tt][1] * fast_exp(tot1 - b1);
            }
            cum0 += tot0; cum1 += tot1;
            *(LAS u32x4*)(lds + KT + ((2 * dp) * 72 + seg * 8) * 2) = (u32x4){pk_bf16(kt0[0], kt0[1]), pk_bf16(kt0[2], kt0[3]), pk_bf16(kt0[4], kt0[5]), pk_bf16(kt0[6], kt0[7])};
            *(LAS u32x4*)(lds + KT + ((2 * dp + 1) * 72 + seg * 8) * 2) = (u32x4){pk_bf16(kt1[0], kt1[1]), pk_bf16(kt1[2], kt1[3]), pk_bf16(kt1[4], kt1[5]), pk_bf16(kt1[6], kt1[7])};
            __syncthreads();
            if (c + 1 < c0 + 16) HG_LOAD(c + 1);
#pragma unroll
            for (int ii = 0; ii < 2; ++ii) {
                const int idx = wid + 8 * ii, st = idx >> 2, tt = idx & 3;
                f32x4 a = (f32x4){0.f, 0.f, 0.f, 0.f};
                if (st <= tt) {
#pragma unroll
                    for (int ks = 0; ks < 4; ++ks) {
                        const bf16x8 ka = *(const LAS bf16x8*)(lds + KH + ((st * 16 + fr) * 136 + ks * 32 + fq * 8) * 2);
                        const bf16x8 qb = *(const LAS bf16x8*)(lds + QT + ((tt * 16 + fr) * 136 + ks * 32 + fq * 8) * 2);
                        a = mfma16(ka, qb, a);
                    }
                    if (st == tt) {
#pragma unroll
                        for (int j = 0; j < 4; ++j) if (fq * 4 + j > fr) a[j] = 0.f;
                    }
                }
                u32x2 w; w.x = pk_bf16(a[0], a[1]); w.y = pk_bf16(a[2], a[3]);
                *(LAS u32x2*)(lds + PM + ((tt * 16 + fr) * 72 + st * 16 + fq * 4) * 2) = w;
            }
            __syncthreads();
            const int ott = wid & 3, ovb = (wid >> 2) * 4;
            f32x4 oacc[4];
#pragma unroll
            for (int vi = 0; vi < 4; ++vi) {
                const int vt = ovb + vi;
                f32x4 a = (f32x4){0.f, 0.f, 0.f, 0.f};
#pragma unroll
                for (int ks = 0; ks < 4; ++ks) {
                    const bf16x8 sa = *(const LAS bf16x8*)(lds + ST + ((vt * 16 + fr) * 136 + ks * 32 + fq * 8) * 2);
                    const bf16x8 qb = *(const LAS bf16x8*)(lds + QT + ((ott * 16 + fr) * 136 + ks * 32 + fq * 8) * 2);
                    a = mfma16(sa, qb, a);
                }
#pragma unroll
                for (int ks = 0; ks < 2; ++ks) {
                    const bf16x8 va = *(const LAS bf16x8*)(lds + VT + ((vt * 16 + fr) * 72 + ks * 32 + fq * 8) * 2);
                    const bf16x8 pb = *(const LAS bf16x8*)(lds + PM + ((ott * 16 + fr) * 72 + ks * 32 + fq * 8) * 2);
                    a = mfma16(va, pb, a);
                }
                oacc[vi] = a;
            }
            {
                const f32x4 dec4 = *(const LAS f32x4*)(lds + DEC + (wid * 16 + fq * 4) * 4);
                bf16x8 ka[2];
#pragma unroll
                for (int ks = 0; ks < 2; ++ks) ka[ks] = *(const LAS bf16x8*)(lds + KT + ((wid * 16 + fr) * 72 + ks * 32 + fq * 8) * 2);
#pragma unroll
                for (int vt = 0; vt < 8; ++vt) {
                    f32x4 a = Sacc[vt] * dec4;
#pragma unroll
                    for (int ks = 0; ks < 2; ++ks) {
                        const bf16x8 vb = *(const LAS bf16x8*)(lds + VT + ((vt * 16 + fr) * 72 + ks * 32 + fq * 8) * 2);
                        a = mfma16(ka[ks], vb, a);
                    }
                    Sacc[vt] = a;
                }
            }
#pragma unroll
            for (int vi = 0; vi < 4; ++vi) { u32x2 w; w.x = pk_bf16(oacc[vi][0], oacc[vi][1]); w.y = pk_bf16(oacc[vi][2], oacc[vi][3]); *(u32x2*)(OL + (row0 + ott * 16 + fr) * 1024 + h * 128 + (ovb + vi) * 16 + fq * 4) = w; }
            __syncthreads();
#pragma unroll
            for (int vt = 0; vt < 8; ++vt) {
                u32x2 w; w.x = pk_bf16(Sacc[vt][0], Sacc[vt][1]); w.y = pk_bf16(Sacc[vt][2], Sacc[vt][3]);
                *(LAS u32x2*)(lds + ST + ((vt * 16 + fr) * 136 + wid * 16 + fq * 4) * 2) = w;
            }
        }
        float* send = (float*)(p.ws + OFF_SEND) + (size_t)unit * 16384;
#pragma unroll
        for (int vt = 0; vt < 8; ++vt)
#pragma unroll
            for (int j = 0; j < 4; ++j) send[(wid * 16 + fq * 4 + j) * 128 + vt * 16 + fr] = Sacc[vt][j];
        if (seg == 0) *(f2_t*)((float*)(p.ws + OFF_DSEG) + unit * 128 + 2 * dp) = (f2_t){fast_exp(cum0), fast_exp(cum1)};
        __syncthreads();
    }
#undef HG_LOAD
}

DI void hgrn_phase2(int wave_id, const Params& p, LAS unsigned char* lds) {
    constexpr int QT = 0, OB = 34816, ST = 71680;
    const int tid = phase_tid(wave_id), lane = tid & 63, wid = __builtin_amdgcn_readfirstlane(tid >> 6), fr = lane & 15, fq = lane >> 4;
    const bf16_t* HQ = (const bf16_t*)(p.ws + OFF_HQ);
    const bf16_t* HGt = (const bf16_t*)(p.ws + OFF_HQ + 192 * MiB);
    const bf16_t* OL = (const bf16_t*)p.out;
    bf16_t* OG = (bf16_t*)(p.ws + OFF_OG);
    const int er = tid >> 3, ep = tid & 7;
    for (int unit = blockIdx.x; unit < 256; unit += gridDim.x) {
        const int b = unit >> 5, h = (unit >> 2) & 7, sg = unit & 3, c0 = sg * 16;
        {
            const float* send = (const float*)(p.ws + OFF_SEND) + (size_t)(unit - sg) * 16384;
            const float* dsg = (const float*)(p.ws + OFF_DSEG) + (unit - sg) * 128;
#pragma unroll
            for (int i0 = 0; i0 < 32; i0 += 8) {
                float sv[8][3], dv[8][3];
#pragma unroll
                for (int i = 0; i < 8; ++i) {
                    const int e = tid + 512 * (i0 + i), d = e >> 7;
#pragma unroll
                    for (int s2 = 0; s2 < 3; ++s2) { sv[i][s2] = send[(size_t)s2 * 16384 + e]; dv[i][s2] = dsg[s2 * 128 + d]; }
                }
#pragma unroll
                for (int i = 0; i < 8; ++i) {
                    const int e = tid + 512 * (i0 + i), d = e >> 7, v = e & 127;
                    float S = 0.f;
#pragma unroll
                    for (int s2 = 0; s2 < 3; ++s2) { const bool on = s2 < sg; S = (on ? dv[i][s2] : 1.f) * S + (on ? sv[i][s2] : 0.f); }
                    *(LAS bf16_t*)(lds + ST + (v * 136 + d) * 2) = bf16_1(S);
                }
            }
        }
        u32x4 qv[2] = {(u32x4){0u, 0u, 0u, 0u}, (u32x4){0u, 0u, 0u, 0u}};
        if (sg > 0) {
            qv[0] = *(const u32x4*)(HQ + ((size_t)b * SEQ_ + (size_t)c0 * 64 + (tid >> 4)) * 1024 + h * 128 + (tid & 15) * 8);
            qv[1] = *(const u32x4*)(HQ + ((size_t)b * SEQ_ + (size_t)c0 * 64 + 32 + (tid >> 4)) * 1024 + h * 128 + (tid & 15) * 8);
        }
        for (int c = c0; c < c0 + 16; ++c) {
            const size_t row0 = (size_t)b * SEQ_ + (size_t)c * 64;
            *(LAS u32x4*)(lds + QT + ((tid >> 4) * 136 + (tid & 15) * 8) * 2) = qv[0];
            *(LAS u32x4*)(lds + QT + ((32 + (tid >> 4)) * 136 + (tid & 15) * 8) * 2) = qv[1];
            f32x4 ol[4];
            {
                const u32x4 oa = *(const u32x4*)(OL + (row0 + er) * 1024 + h * 128 + ep * 16), ob = *(const u32x4*)(OL + (row0 + er) * 1024 + h * 128 + ep * 16 + 8);
                ol[0] = (f32x4){__uint_as_float(oa.x << 16), __uint_as_float(oa.x & 0xffff0000u), __uint_as_float(oa.y << 16), __uint_as_float(oa.y & 0xffff0000u)};
                ol[1] = (f32x4){__uint_as_float(oa.z << 16), __uint_as_float(oa.z & 0xffff0000u), __uint_as_float(oa.w << 16), __uint_as_float(oa.w & 0xffff0000u)};
                ol[2] = (f32x4){__uint_as_float(ob.x << 16), __uint_as_float(ob.x & 0xffff0000u), __uint_as_float(ob.y << 16), __uint_as_float(ob.y & 0xffff0000u)};
                ol[3] = (f32x4){__uint_as_float(ob.z << 16), __uint_as_float(ob.z & 0xffff0000u), __uint_as_float(ob.w << 16), __uint_as_float(ob.w & 0xffff0000u)};
            }
            const bf16x8 gt0 = *(const bf16x8*)(HGt + (row0 + er) * 1024 + h * 128 + ep * 16);
            const bf16x8 gt1 = *(const bf16x8*)(HGt + (row0 + er) * 1024 + h * 128 + ep * 16 + 8);
            __syncthreads();
            if (sg > 0 && c + 1 < c0 + 16) {
                qv[0] = *(const u32x4*)(HQ + (row0 + 64 + (tid >> 4)) * 1024 + h * 128 + (tid & 15) * 8);
                qv[1] = *(const u32x4*)(HQ + (row0 + 64 + 32 + (tid >> 4)) * 1024 + h * 128 + (tid & 15) * 8);
            }
            const int ott = wid & 3, ovb = (wid >> 2) * 4;
#pragma unroll
            for (int vi = 0; vi < 4; ++vi) {
                const int vt = ovb + vi;
                f32x4 a = (f32x4){0.f, 0.f, 0.f, 0.f};
                if (sg > 0) {
#pragma unroll
                    for (int ks = 0; ks < 4; ++ks) {
                        const bf16x8 sa = *(const LAS bf16x8*)(lds + ST + ((vt * 16 + fr) * 136 + ks * 32 + fq * 8) * 2);
                        const bf16x8 qb = *(const LAS bf16x8*)(lds + QT + ((ott * 16 + fr) * 136 + ks * 32 + fq * 8) * 2);
                        a = mfma16(sa, qb, a);
                    }
                }
                *(LAS f32x4*)(lds + OB + ((ott * 16 + fr) * 132 + vt * 16 + fq * 4) * 4) = a;
            }
            __syncthreads();
            {
                f32x4 ov[4]; float sq = 0.f;
#pragma unroll
                for (int i = 0; i < 4; ++i) { ov[i] = *(const LAS f32x4*)(lds + OB + (er * 132 + ep * 16 + i * 4) * 4) + ol[i]; sq += (ov[i][0] * ov[i][0] + ov[i][1] * ov[i][1]) + (ov[i][2] * ov[i][2] + ov[i][3] * ov[i][3]); }
                sq += __shfl_xor(sq, 1); sq += __shfl_xor(sq, 2); sq += __shfl_xor(sq, 4);
                const float sc = rsqrtf(sq * (1.0f / 128.0f) + EPS_);
                unsigned w[8];
#pragma unroll
                for (int i = 0; i < 4; ++i) {
                    const f32x4 gn = *(const f32x4*)(p.g_norm + ep * 16 + i * 4);
                    float r[4];
#pragma unroll
                    for (int j = 0; j < 4; ++j) {
                        const int e = i * 4 + j;
                        const float gate = bf2f((unsigned short)(e < 8 ? gt0[e] : gt1[e - 8]));
                        r[j] = ov[i][j] * sc * gn[j] * gate;
                    }
                    w[i * 2] = pk_bf16(r[0], r[1]); w[i * 2 + 1] = pk_bf16(r[2], r[3]);
                }
                bf16_t* op = OG + (row0 + er) * 1024 + h * 128 + ep * 16;
                *(u32x4*)op = (u32x4){w[0], w[1], w[2], w[3]};
                *(u32x4*)(op + 8) = (u32x4){w[4], w[5], w[6], w[7]};
            }
        }
        __syncthreads();
    }
}

struct AttU { int b, h, qb; };
DI void attn_unit(int wave_id, const bf16_t* Q, const bf16_t* KN, const bf16_t* KR, const bf16_t* VTg, bf16_t* O, const AttU u, const AttU nu, bool has_next,
                  bf16x8 (&qf)[12], u32x4 (&stg)[5], LAS unsigned char* lds) {
    constexpr int KSTR = 400, VSTR = 144, KBYTES = 64 * KSTR, STAGE = KBYTES + 128 * VSTR;
    const int tid = phase_tid(wave_id), lane = tid & 63, wid = __builtin_amdgcn_readfirstlane(tid >> 6), r = lane & 31, hh = lane >> 5;
    const int b = u.b, h = u.h, qb = u.qb;
    const int q0 = qb * 256 + wid * 32;
    f32x16 o[4];
#pragma unroll
    for (int i = 0; i < 4; ++i)
#pragma unroll
        for (int j = 0; j < 16; ++j) o[i][j] = 0.f;
    float m_run = -1e30f, l_run = 0.f;
    const int ntiles = 4 * qb + 4;
    const char* gKN = (const char*)(KN + (size_t)(b * SEQ_) * 2048 + h * 128);
    const char* gKR = (const char*)(KR + (size_t)(b * SEQ_) * 64);
    const char* gVT = (const char*)(VTg + (size_t)(b * 2048 + h * 128) * SEQ_);
    const unsigned gn0 = (unsigned)(((tid >> 4) * 2048 + (tid & 15) * 8) * 2), ln0 = (unsigned)((tid >> 4) * KSTR + (tid & 15) * 16);
    const unsigned gr0 = (unsigned)(tid * 16), lr0 = (unsigned)((tid >> 3) * KSTR + 256 + (tid & 7) * 16);
    const unsigned gv0 = (unsigned)(((tid >> 3) * SEQ_ + (tid & 7) * 8) * 2), lv0 = (unsigned)(KBYTES + (tid >> 3) * VSTR + (tid & 7) * 16);
#define ATT_LOADP(pKN_, pKR_, pVT_, kt_) do { \
        stg[0] = *(const u32x4*)((pKN_) + (size_t)(kt_) * (64 * 2048 * 2) + gn0); \
        stg[1] = *(const u32x4*)((pKN_) + (size_t)(kt_) * (64 * 2048 * 2) + 32 * 2048 * 2 + gn0); \
        stg[2] = *(const u32x4*)((pKR_) + (size_t)(kt_) * (64 * 64 * 2) + gr0); \
        stg[3] = *(const u32x4*)((pVT_) + (size_t)(kt_) * 128 + gv0); \
        stg[4] = *(const u32x4*)((pVT_) + (size_t)(kt_) * 128 + 64 * SEQ_ * 2 + gv0); } while (0)
#define ATT_LOAD(kt_) ATT_LOADP(gKN, gKR, gVT, kt_)
#define ATT_STORE(buf_) do { \
        *(LAS u32x4*)(lds + (buf_) + ln0) = stg[0]; *(LAS u32x4*)(lds + (buf_) + 32 * KSTR + ln0) = stg[1]; \
        *(LAS u32x4*)(lds + (buf_) + lr0) = stg[2]; \
        *(LAS u32x4*)(lds + (buf_) + lv0) = stg[3]; *(LAS u32x4*)(lds + (buf_) + 64 * VSTR + lv0) = stg[4]; } while (0)
    ATT_STORE(0);
    __syncthreads();
    for (int kt = 0; kt < ntiles; ++kt) {
        const int cur = (kt & 1) * STAGE, nxt = ((kt + 1) & 1) * STAGE;
        const bool more = (kt + 1 < ntiles);
        __builtin_amdgcn_s_setprio(1);
        if (more) ATT_LOAD(kt + 1);
        const int key0 = kt * 64;
        if (key0 <= q0 + 31) {
            const bool act1 = (key0 + 32 <= q0 + 31);
            f32x16 s0, s1;
#pragma unroll
            for (int j = 0; j < 16; ++j) { s0[j] = 0.f; s1[j] = 0.f; }
            const unsigned kb0 = cur + r * KSTR + 16 * hh, kb1 = kb0 + 32 * KSTR;
            if (act1) {
                bf16x8 ka[4], kc[4];
#pragma unroll
                for (int i = 0; i < 4; ++i) { ka[i] = *(const LAS bf16x8*)(lds + kb0 + 32 * i); kc[i] = *(const LAS bf16x8*)(lds + kb1 + 32 * i); }
#pragma unroll
                for (int ks = 0; ks < 12; ++ks) {
                    s0 = mfma32(ka[ks & 3], qf[ks], s0);
                    s1 = mfma32(kc[ks & 3], qf[ks], s1);
                    if (ks + 4 < 12) { ka[ks & 3] = *(const LAS bf16x8*)(lds + kb0 + 32 * (ks + 4)); kc[ks & 3] = *(const LAS bf16x8*)(lds + kb1 + 32 * (ks + 4)); }
                }
            } else {
                bf16x8 ka[4];
#pragma unroll
                for (int i = 0; i < 4; ++i) ka[i] = *(const LAS bf16x8*)(lds + kb0 + 32 * i);
#pragma unroll
                for (int ks = 0; ks < 12; ++ks) {
                    s0 = mfma32(ka[ks & 3], qf[ks], s0);
                    if (ks + 4 < 12) ka[ks & 3] = *(const LAS bf16x8*)(lds + kb0 + 32 * (ks + 4));
                }
            }
            const int qpos = q0 + r;
            if (key0 + 63 > q0) {
#pragma unroll
                for (int j = 0; j < 16; ++j) {
                    const int kr = (j & 3) + 8 * (j >> 2) + 4 * hh;
                    if (key0 + kr > qpos) s0[j] = -INFINITY;
                    if (!act1 || key0 + 32 + kr > qpos) s1[j] = -INFINITY;
                }
            }
            float mx = s0[0];
#pragma unroll
            for (int j = 1; j < 16; ++j) mx = fmaxf(mx, s0[j]);
#pragma unroll
            for (int j = 0; j < 16; ++j) mx = fmaxf(mx, s1[j]);
            { const u32x2 sw = __builtin_amdgcn_permlane32_swap(__float_as_uint(mx), __float_as_uint(mx), false, false);
              mx = fmaxf(__uint_as_float(sw.x), __uint_as_float(sw.y)); }
            const float m_new = fmaxf(m_run, mx);
            const bool grow = __builtin_amdgcn_ballot_w64(m_new > m_run) != 0ull;
            const float alpha = __builtin_amdgcn_exp2f(m_run - m_new);
            m_run = m_new;
            float rs = 0.f;
#pragma unroll
            for (int j = 0; j < 16; ++j) { s0[j] = __builtin_amdgcn_exp2f(s0[j] - m_new); rs += s0[j]; }
#pragma unroll
            for (int j = 0; j < 16; ++j) { s1[j] = __builtin_amdgcn_exp2f(s1[j] - m_new); rs += s1[j]; }
            if (grow) {
                l_run *= alpha;
#pragma unroll
                for (int i = 0; i < 4; ++i)
#pragma unroll
                    for (int j = 0; j < 16; ++j) o[i][j] *= alpha;
            }
            l_run += rs;
#pragma unroll
            for (int s2 = 0; s2 < 2; ++s2) {
                u32x4 pw;
                pw.x = pk_bf16(s0[8 * s2 + 0], s0[8 * s2 + 1]); pw.y = pk_bf16(s0[8 * s2 + 2], s0[8 * s2 + 3]);
                pw.z = pk_bf16(s0[8 * s2 + 4], s0[8 * s2 + 5]); pw.w = pk_bf16(s0[8 * s2 + 6], s0[8 * s2 + 7]);
                const bf16x8 pb = __builtin_bit_cast(bf16x8, pw);
#pragma unroll
                for (int vt = 0; vt < 4; ++vt) {
                    const bf16x8 vf = *(const LAS bf16x8*)(lds + cur + KBYTES + (32 * vt + r) * VSTR + (16 * s2 + 8 * hh) * 2);
                    o[vt] = mfma32(vf, pb, o[vt]);
                }
            }
            if (act1) {
#pragma unroll
                for (int s2 = 0; s2 < 2; ++s2) {
                    u32x4 pw;
                    pw.x = pk_bf16(s1[8 * s2 + 0], s1[8 * s2 + 1]); pw.y = pk_bf16(s1[8 * s2 + 2], s1[8 * s2 + 3]);
                    pw.z = pk_bf16(s1[8 * s2 + 4], s1[8 * s2 + 5]); pw.w = pk_bf16(s1[8 * s2 + 6], s1[8 * s2 + 7]);
                    const bf16x8 pb = __builtin_bit_cast(bf16x8, pw);
#pragma unroll
                    for (int vt = 0; vt < 4; ++vt) {
                        const bf16x8 vf = *(const LAS bf16x8*)(lds + cur + KBYTES + (32 * vt + r) * VSTR + (32 + 16 * s2 + 8 * hh) * 2);
                        o[vt] = mfma32(vf, pb, o[vt]);
                    }
                }
            }
        }
        __builtin_amdgcn_s_setprio(0);
        if (more) ATT_STORE(nxt);
        __syncthreads();
    }
    if (has_next) {
        const bf16_t* qp = Q + ((size_t)(nu.b * SEQ_ + nu.qb * 256 + wid * 32 + r) * 3072 + nu.h * 192 + 8 * hh);
#pragma unroll
        for (int ks = 0; ks < 12; ++ks) qf[ks] = *(const bf16x8*)(qp + 16 * ks);
        const char* nKN = (const char*)(KN + (size_t)(nu.b * SEQ_) * 2048 + nu.h * 128);
        const char* nKR = (const char*)(KR + (size_t)(nu.b * SEQ_) * 64);
        const char* nVT = (const char*)(VTg + (size_t)(nu.b * 2048 + nu.h * 128) * SEQ_);
        ATT_LOADP(nKN, nKR, nVT, 0);
    }
    const u32x2 lsw = __builtin_amdgcn_permlane32_swap(__float_as_uint(l_run), __float_as_uint(l_run), false, false);
    const float lt = __uint_as_float(lsw.x) + __uint_as_float(lsw.y);
    const float inv = 1.0f / lt;
    bf16_t* op = O + ((size_t)(b * SEQ_ + q0 + r) * 3072 + h * 192);
#pragma unroll
    for (int vt = 0; vt < 4; ++vt)
#pragma unroll
        for (int gq = 0; gq < 4; ++gq) {
            u32x2 w; w.x = pk_bf16(o[vt][4 * gq] * inv, o[vt][4 * gq + 1] * inv); w.y = pk_bf16(o[vt][4 * gq + 2] * inv, o[vt][4 * gq + 3] * inv);
            *(u32x2*)(op + 32 * vt + 8 * gq + 4 * hh) = w;
        }
#undef ATT_LOAD
#undef ATT_LOADP
#undef ATT_STORE
}

DI AttU attn_sched(int i) {
    const int b = blockIdx.x & 7, j = blockIdx.x >> 3;
    return AttU{b, 2 * i + (j >> 4), (i & 1) ? (j & 15) : 15 - (j & 15)};
}

DI void attn_phase(int wave_id, const Params& p, LAS unsigned char* lds) {
    const bf16_t* Q = (const bf16_t*)(p.ws + OFF_Q);
    const bf16_t* KN = (const bf16_t*)(p.ws + OFF_KN);
    const bf16_t* KR = (const bf16_t*)(p.ws + OFF_KR);
    const bf16_t* VTg = (const bf16_t*)(p.ws + OFF_VT);
    bf16_t* O = (bf16_t*)(p.ws + OFF_Q);
    const int tid = phase_tid(wave_id), lane = tid & 63, wid = __builtin_amdgcn_readfirstlane(tid >> 6), r = lane & 31, hh = lane >> 5;
    bf16x8 qf[12]; u32x4 stg[5];
    const bool sched256 = gridDim.x == 256;
    const int nunits = sched256 ? 8 : (2048 - (int)blockIdx.x + (int)gridDim.x - 1) / (int)gridDim.x;
#define ATT_UNIT_OF(i_) (sched256 ? attn_sched(i_) : AttU{(int)((blockIdx.x + (i_) * gridDim.x) & 7), (int)(((blockIdx.x + (i_) * gridDim.x) >> 3) & 15), (int)((blockIdx.x + (i_) * gridDim.x) >> 7)})
    if (nunits > 0) {
        const AttU u0 = ATT_UNIT_OF(0);
        const bf16_t* qp = Q + ((size_t)(u0.b * SEQ_ + u0.qb * 256 + wid * 32 + r) * 3072 + u0.h * 192 + 8 * hh);
#pragma unroll
        for (int ks = 0; ks < 12; ++ks) qf[ks] = *(const bf16x8*)(qp + 16 * ks);
        const char* nKN = (const char*)(KN + (size_t)(u0.b * SEQ_) * 2048 + u0.h * 128);
        const char* nKR = (const char*)(KR + (size_t)(u0.b * SEQ_) * 64);
        const char* nVT = (const char*)(VTg + (size_t)(u0.b * 2048 + u0.h * 128) * SEQ_);
        stg[0] = *(const u32x4*)(nKN + (unsigned)(((tid >> 4) * 2048 + (tid & 15) * 8) * 2));
        stg[1] = *(const u32x4*)(nKN + 32 * 2048 * 2 + (unsigned)(((tid >> 4) * 2048 + (tid & 15) * 8) * 2));
        stg[2] = *(const u32x4*)(nKR + (unsigned)(tid * 16));
        stg[3] = *(const u32x4*)(nVT + (unsigned)(((tid >> 3) * SEQ_ + (tid & 7) * 8) * 2));
        stg[4] = *(const u32x4*)(nVT + 64 * SEQ_ * 2 + (unsigned)(((tid >> 3) * SEQ_ + (tid & 7) * 8) * 2));
    }
    for (int i = 0; i < nunits; ++i)
        attn_unit(wave_id, Q, KN, KR, VTg, O, ATT_UNIT_OF(i), ATT_UNIT_OF(i + 1 < nunits ? i + 1 : i), i + 1 < nunits, qf, stg, lds);
#undef ATT_UNIT_OF
}

DI void final_phase(int wave_id, const Params& p) {
    const int tid = phase_tid(wave_id), lane = tid & 63, wid = tid >> 6;
    const float* ss = (const float*)(p.ws + OFF_SS) + 4 * (size_t)T_;
    const bf16_t* hb = (const bf16_t*)(p.ws + OFF_XB3);
    for (int row = blockIdx.x * 8 + wid; row < T_; row += gridDim.x * 8) {
        const float rs = rsqrtf(ss[row] * (1.0f / 1024.0f) + EPS_);
        f32x4* orow = (f32x4*)(p.out + (size_t)row * 1024);
#pragma unroll
        for (int i = 0; i < 2; ++i) {
            const int c8 = lane + 64 * i;
            const u32x4 hv = *(const u32x4*)(hb + (size_t)row * 1024 + c8 * 8);
            const f32x4 g0 = *(const f32x4*)(p.final_norm + c8 * 8), g1 = *(const f32x4*)(p.final_norm + c8 * 8 + 4);
            orow[c8 * 2] = (f32x4){__uint_as_float(hv.x << 16), __uint_as_float(hv.x & 0xffff0000u), __uint_as_float(hv.y << 16), __uint_as_float(hv.y & 0xffff0000u)} * rs * g0;
            orow[c8 * 2 + 1] = (f32x4){__uint_as_float(hv.z << 16), __uint_as_float(hv.z & 0xffff0000u), __uint_as_float(hv.w << 16), __uint_as_float(hv.w & 0xffff0000u)} * rs * g1;
        }
    }
}

__global__ void __launch_bounds__(512) fwd_megakernel(Params p) {
    extern __shared__ __attribute__((aligned(16))) unsigned char lds_raw[];
    LAS unsigned char* lds = (LAS unsigned char*)lds_raw;
    cg::grid_group grid = cg::this_grid();
    const int wave_id = __builtin_amdgcn_readfirstlane(threadIdx.x >> 6);
    using namespace pg8;
    {
        const int t0 = phase_tid(wave_id);
        if (t0 == 0) { *(LAS u32x4*)(lds + 131072) = (u32x4){0u, 0u, 0u, 0u}; }
        __syncthreads();
    }
    const XcdBarrier xb = xcd_barrier_post((unsigned*)(p.ws + OFF_BAR), (volatile LAS unsigned*)(lds + 131072), phase_tid(wave_id));
#ifndef PHASE_MASK
#define PHASE_MASK 0xffff
#endif
#define PH(i) if ((PHASE_MASK >> (i)) & 1)
#define WSDEF unsigned char* ws = p.ws; asm volatile("" : "+s"(ws)); float* SS = (float*)(ws + OFF_SS); \
    float *ss_x = SS, *ss_h1 = SS + T_, *ss_h2 = SS + 2 * T_, *ss_h3 = SS + 3 * T_, *ss_h4 = SS + 4 * T_, *ss_ckv = SS + 5 * T_, *ss_cq = SS + 6 * T_; \
    bf16_t* XB0 = (bf16_t*)(ws + OFF_XB0); const f2_t* rope = (const f2_t*)(ws + OFF_ROPE); \
    (void)ss_x; (void)ss_h1; (void)ss_h2; (void)ss_h3; (void)ss_h4; (void)ss_ckv; (void)ss_cq; (void)XB0; (void)rope;
    PH(0) prologue_phase(wave_id, p, lds);
    if (p.ws == nullptr) grid.sync();
    xcd_barrier(xb, phase_tid(wave_id));
    PH(1) { WSDEF gemm_phase(wave_id, lds, Gemm{XB0, (const bf16_t*)(ws + OFF_WHG), T_, 3072, 1024, 1024, 256, 0}, EpiHG{ss_x, (const float*)(ws + OFF_LB), (bf16_t*)(ws + OFF_HQ)}); }
    PH(1) { WSDEF gemm_phase(wave_id, lds, Gemm{(const bf16_t*)(ws + OFF_WHG) + (size_t)3072 * 1024, XB0, 1024, T_, 1024, 1024, 256, 0}, EpiHVT{ss_x, (bf16_t*)(ws + OFF_HQ + 128 * MiB)}); }
    xcd_barrier(xb, phase_tid(wave_id));
    PH(2) hgrn_phase1(wave_id, p, lds);
    xcd_barrier(xb, phase_tid(wave_id));
    PH(2) hgrn_phase2(wave_id, p, lds);
    xcd_barrier(xb, phase_tid(wave_id));
    PH(3) { WSDEF gemm_phase(wave_id, lds, Gemm{(const bf16_t*)(ws + OFF_OG), (const bf16_t*)(ws + OFF_WWO), T_, 1024, 1024, 1024, 256, 0}, EpiRes<false>{XB0, XB0, ss_h1}); }
    xcd_barrier(xb, phase_tid(wave_id));
    PH(4) { WSDEF gemm_phase(wave_id, lds, Gemm{XB0, (const bf16_t*)(ws + OFF_WUP0), T_, 4096, 1024, 1024, 256, 0}, EpiRelu2{ss_h1, (bf16_t*)(ws + OFF_HID0)}); }
    xcd_barrier(xb, phase_tid(wave_id));
    PH(5) { WSDEF gemm_phase(wave_id, lds, Gemm{(const bf16_t*)(ws + OFF_HID0), (const bf16_t*)(ws + OFF_WDN0), T_, 1024, 4096, 4096, 256, 1}, EpiRes<false>{XB0, (bf16_t*)p.out, ss_h2}); }
    xcd_barrier(xb, phase_tid(wave_id));
    PH(6) { WSDEF gemm_phase(wave_id, lds, Gemm{(const bf16_t*)p.out, (const bf16_t*)(ws + OFF_WDKVQ), T_, 768, 1024, 1024, 256, 0},
               EpiDKVQ{ss_h2, (bf16_t*)(ws + OFF_CKV), (bf16_t*)(ws + OFF_CQ), (bf16_t*)(ws + OFF_KR), ss_ckv, ss_cq, rope}); }
    xcd_barrier(xb, phase_tid(wave_id));
    PH(7) { WSDEF gemm_phase(wave_id, lds, Gemm{(const bf16_t*)(ws + OFF_CKV), (const bf16_t*)(ws + OFF_WUKV), T_, 2048, 256, 256, 256, 0}, EpiKN{ss_ckv, (bf16_t*)(ws + OFF_KN)}); }
    PH(8) { WSDEF gemm_phase(wave_id, lds, Gemm{(const bf16_t*)(ws + OFF_WUKV) + (size_t)2048 * 256, (const bf16_t*)(ws + OFF_CKV), 2048, T_, 256, 256, 256, 0}, EpiVT{ss_ckv, (bf16_t*)(ws + OFF_VT)}); }
    PH(9) { WSDEF gemm_phase(wave_id, lds, Gemm{(const bf16_t*)(ws + OFF_CQ), (const bf16_t*)(ws + OFF_WUQ), T_, 3072, 256, 256, 256, 0}, EpiQ{ss_cq, (bf16_t*)(ws + OFF_Q), rope}); }
    xcd_barrier(xb, phase_tid(wave_id));
    PH(10) attn_phase(wave_id, p, lds);
    xcd_barrier(xb, phase_tid(wave_id));
    PH(11) { WSDEF gemm_phase(wave_id, lds, Gemm{(const bf16_t*)(ws + OFF_Q), (const bf16_t*)(ws + OFF_WMWO), T_, 1024, 2048, 3072, 384, 0}, EpiRes<false>{(const bf16_t*)p.out, (bf16_t*)(ws + OFF_XB3), ss_h3}); }
    xcd_barrier(xb, phase_tid(wave_id));
    PH(12) { WSDEF gemm_phase(wave_id, lds, Gemm{(const bf16_t*)(ws + OFF_XB3), (const bf16_t*)(ws + OFF_WUP1), T_, 4096, 1024, 1024, 256, 0}, EpiRelu2{ss_h3, (bf16_t*)(ws + OFF_HID1)}); }
    xcd_barrier(xb, phase_tid(wave_id));
    PH(13) { WSDEF gemm_phase(wave_id, lds, Gemm{(const bf16_t*)(ws + OFF_HID1), (const bf16_t*)(ws + OFF_WDN1), T_, 1024, 4096, 4096, 256, 1}, EpiRes<false>{(const bf16_t*)(ws + OFF_XB3), (bf16_t*)(ws + OFF_XB3), ss_h4}); }
    xcd_barrier(xb, phase_tid(wave_id));
    PH(14) final_phase(wave_id, p);
}

extern "C" void kernel_launch(void* const* d_in, const int* in_sizes, int n_in, void* d_out, int out_size, void* d_ws, size_t ws_size, hipStream_t stream) {
    static int grid_blocks = 0;
    if (!grid_blocks) {
        int dev = 0, cus = 0, per_cu = 0;
        hipGetDevice(&dev);
        hipDeviceGetAttribute(&cus, hipDeviceAttributeMultiprocessorCount, dev);
        if (hipFuncSetAttribute((const void*)fwd_megakernel, hipFuncAttributeMaxDynamicSharedMemorySize, LDS_BYTES) != hipSuccess) fprintf(stderr, "hipFuncSetAttribute failed\n");
        hipOccupancyMaxActiveBlocksPerMultiprocessor(&per_cu, (const void*)fwd_megakernel, 512, LDS_BYTES);
        if (per_cu < 1) per_cu = 1;
        grid_blocks = cus * per_cu;
        if (grid_blocks > 256) grid_blocks = 256;
        if (ws_size < WS_NEED) fprintf(stderr, "workspace too small: %zu < %zu\n", ws_size, (size_t)WS_NEED);
    }
    Params p{};
    const float** pp = (const float**)&p;
    for (int i = 0; i < 23; ++i) pp[i] = (const float*)d_in[i];
    p.out = (float*)d_out;
    p.ws = (unsigned char*)d_ws;
    hipMemsetAsync((unsigned char*)d_ws + OFF_BAR, 0, XCD_BAR_WORDS * 4, stream);
    void* args[] = {&p};
    hipError_t e = hipLaunchCooperativeKernel((const void*)fwd_megakernel, dim3(grid_blocks), dim3(512), args, LDS_BYTES, stream);
    if (e != hipSuccess) fprintf(stderr, "cooperative launch failed: %s (grid %d)\n", hipGetErrorString(e), grid_blocks);
}
```

```cpp
#include <hip/hip_runtime.h>
#include <hip/hip_cooperative_groups.h>
#include <cstdio>
#include <cstdint>
namespace cg = cooperative_groups;

#define LAS __attribute__((address_space(3)))
#define DI __device__ __forceinline__
typedef unsigned short bf16_t;
typedef short bf16x8 __attribute__((ext_vector_type(8)));
typedef float f32x4 __attribute__((ext_vector_type(4)));
typedef float f32x16 __attribute__((ext_vector_type(16)));
typedef unsigned u32x4 __attribute__((ext_vector_type(4)));
typedef unsigned u32x2 __attribute__((ext_vector_type(2)));
typedef __bf16 bf2_t __attribute__((ext_vector_type(2)));
typedef float f2_t __attribute__((ext_vector_type(2)));
typedef _Float16 h2_t __attribute__((ext_vector_type(2)));

constexpr int T_ = 32768;
constexpr int SEQ_ = 4096;
constexpr float EPS_ = 1e-6f;
constexpr size_t MiB = 1ull << 20;
constexpr size_t OFF_A = 0, OFF_B = 256 * MiB, OFF_C = 448 * MiB;
constexpr size_t OFF_HQ = OFF_A;
constexpr size_t OFF_HID0 = OFF_A;
constexpr size_t OFF_KN = OFF_A, OFF_VT = OFF_A + 128 * MiB;
constexpr size_t OFF_XB3 = OFF_A;
constexpr size_t OFF_HID1 = OFF_A + 64 * MiB;
constexpr size_t OFF_XB0 = OFF_B;
constexpr size_t OFF_OG = OFF_B + 64 * MiB;
constexpr size_t OFF_WHG = OFF_B + 128 * MiB;
constexpr size_t OFF_WWO = OFF_WHG + 8 * MiB;
constexpr size_t OFF_WUP0 = OFF_WWO + 2 * MiB;
constexpr size_t OFF_WDN0 = OFF_WUP0 + 8 * MiB;
constexpr size_t OFF_WDKVQ = OFF_WDN0 + 8 * MiB;
constexpr size_t OFF_Q = OFF_B;
constexpr size_t OFF_CKV = OFF_C, OFF_CQ = OFF_C + 16 * MiB, OFF_KR = OFF_C + 32 * MiB;
constexpr size_t OFF_WUKV = OFF_C + 36 * MiB;
constexpr size_t OFF_WUQ = OFF_WUKV + 2 * MiB;
constexpr size_t OFF_WMWO = OFF_WUQ + 3 * MiB / 2;
constexpr size_t OFF_WUP1 = OFF_WMWO + 4 * MiB;
constexpr size_t OFF_WDN1 = OFF_WUP1 + 8 * MiB;
constexpr size_t OFF_ROPE = OFF_WDN1 + 8 * MiB;
constexpr size_t OFF_SS = OFF_ROPE + 1 * MiB;
constexpr size_t OFF_LB = OFF_SS + 7 * (size_t)T_ * 4;
constexpr size_t WS_NEED = OFF_LB + 65536 + 16384;
constexpr size_t OFF_BAR = OFF_LB + 65536;
constexpr int LDS_BYTES = 131072 + 16;

struct Params {
    const float *x, *hgrn_norm, *w_q, *w_f, *w_i, *w_g, *g_norm, *w_o, *lb_logits, *mla_norm, *w_dq, *q_norm, *w_uq, *mla_w_o,
        *kv_in_norm, *w_dkv, *kv_norm, *w_uk, *w_uv, *mlp_norm, *w_up, *w_down, *final_norm;
    float* out;
    unsigned char* ws;
};

DI int phase_tid(int w) {
    asm volatile("" : "+s"(w));
    int l;
    asm volatile("v_mbcnt_lo_u32_b32 %0, -1, 0\n\tv_mbcnt_hi_u32_b32 %0, -1, %0" : "=v"(l));
    return w * 64 + l;
}
DI unsigned pk_bf16(float a, float b) { f2_t f = {a, b}; bf2_t h = __builtin_convertvector(f, bf2_t); return __builtin_bit_cast(unsigned, h); }
DI unsigned pk_f16(float a, float b) { f2_t f = {a, b}; h2_t h = __builtin_convertvector(f, h2_t); return __builtin_bit_cast(unsigned, h); }
DI bf16_t bf16_1(float a) { return (bf16_t)(pk_bf16(a, 0.f) & 0xffffu); }
DI float bf2f(unsigned short b) { return __uint_as_float((unsigned)b << 16); }
DI float fast_exp(float x) { return __builtin_amdgcn_exp2f(x * 1.4426950408889634f); }
DI float fast_rcp(float x) { return __builtin_amdgcn_rcpf(x); }
DI float sigmoidf_(float x) { return fast_rcp(1.0f + fast_exp(-x)); }

#define XB_TMO      128
#define XB_XCNT(j)  (256  + 64 * (j))
#define XB_XSUB(j)  (1280 + 64 * (j))
#define XB_XGEN(j)  (2304 + 64 * (j))
#define XB_TOP      3328
#define XB_TOPGEN   3392
#define XCD_BAR_WORDS 3456
#define XB_SPIN_CAP (1u << 18)

__device__ __forceinline__ unsigned xb_ld(unsigned* p)              { return __hip_atomic_load(p, __ATOMIC_RELAXED, __HIP_MEMORY_SCOPE_AGENT); }
__device__ __forceinline__ unsigned xb_add(unsigned* p, unsigned v) { return __hip_atomic_fetch_add(p, v, __ATOMIC_RELAXED, __HIP_MEMORY_SCOPE_AGENT); }
__device__ __forceinline__ unsigned xb_xcc_id() { return (unsigned)__builtin_amdgcn_s_getreg((3 << 11) | 20) & 0xFu; }
#define XB_SPIN(cond, bar) do { unsigned _sp = 0; while (cond) { __builtin_amdgcn_s_sleep(1); \
    if ((++_sp & 255u) == 0u) { if (xb_ld(&(bar)[XB_TMO])) break; if (_sp > XB_SPIN_CAP) { atomicAdd(&(bar)[XB_TMO], 1u); break; } } } } while (0)

struct XcdBarrier {
    unsigned* bar; unsigned x;
    volatile LAS unsigned* st;
};

__device__ __forceinline__ XcdBarrier xcd_barrier_post(unsigned* bar, volatile LAS unsigned* st, int tid) {
    XcdBarrier b; b.bar = bar; b.x = xb_xcc_id(); b.st = st;
    if (tid == 0) (void)xb_add(&bar[XB_XCNT(b.x)], 1u);
    return b;
}
__device__ __forceinline__ void xcd_barrier_complete(unsigned* bar, unsigned x, unsigned& nloc, unsigned& nx) {
    const unsigned G = gridDim.x * gridDim.y * gridDim.z;
    unsigned sum, cnt, mine, sp = 0u;
    for (;;) {
        sum = 0u; cnt = 0u; mine = 0u;
#pragma unroll
        for (unsigned j = 0; j < 16; ++j) { const unsigned c = xb_ld(&bar[XB_XCNT(j)]); sum += c; cnt += (c > 0u) ? 1u : 0u; mine = (j == x) ? c : mine; }
        if (sum == G) break;
        __builtin_amdgcn_s_sleep(1);
        if ((++sp & 255u) == 0u) { if (xb_ld(&bar[XB_TMO])) break; if (sp > XB_SPIN_CAP) { atomicAdd(&bar[XB_TMO], 1u); break; } }
    }
    nloc = mine > 0u ? mine : 1u; nx = cnt > 0u ? cnt : 1u;
}

__device__ __forceinline__ void xcd_barrier(const XcdBarrier& b, int tid) {
    asm volatile("s_waitcnt vmcnt(0)" ::: "memory");
    __syncthreads();
    if (tid == 0) {
        unsigned* bar = b.bar;
        __builtin_amdgcn_s_waitcnt(0);
        unsigned nloc = b.st[0], nx = b.st[1];
        if (nloc == 0u) { xcd_barrier_complete(bar, b.x, nloc, nx); b.st[0] = nloc; b.st[1] = nx; }
        const unsigned old = xb_add(&bar[XB_XSUB(b.x)], 1u);
        const unsigned gen = old / nloc;
        if (old + 1u == (gen + 1u) * nloc) {
            __builtin_amdgcn_fence(__ATOMIC_RELEASE, "agent");
            asm volatile("s_waitcnt vmcnt(0)" ::: "memory");
            const unsigned og = xb_add(&bar[XB_TOP], 1u);
            const unsigned tg = og / nx;
            if (og + 1u == (tg + 1u) * nx) xb_add(&bar[XB_TOPGEN], 1u);
            else XB_SPIN(xb_ld(&bar[XB_TOPGEN]) == tg, bar);
            __builtin_amdgcn_fence(__ATOMIC_ACQUIRE, "agent");
            xb_add(&bar[XB_XGEN(b.x)], 1u);
            asm volatile("s_waitcnt vmcnt(0)" ::: "memory");
        } else {
            XB_SPIN(xb_ld(&bar[XB_XGEN(b.x)]) == gen, bar);
            __builtin_amdgcn_fence(__ATOMIC_ACQUIRE, "agent");
            asm volatile("s_waitcnt vmcnt(0)" ::: "memory");
        }
    }
    __syncthreads();
}

namespace pg8 {
constexpr int BM = 256, BK = 64, HALF = 128, HTB = HALF * BK * 2, NXCD = 8, WGM = 8;
DI int lds_byte(int r, int c) { const int st = (r >> 4) * 2 + (c >> 5), rr = r & 15, cc = c & 31, ob = rr * 64 + cc * 2; return st * 1024 + (ob ^ (((ob >> 9) & 1) << 5)); }
DI void stage_rc(int b, int& R, int& C) { const int st = b / 1024, sb = b % 1024, swz = sb ^ (((sb >> 9) & 1) << 5); R = (st >> 1) * 16 + swz / 64; C = (st & 1) * 32 + (swz % 64) / 2; }
DI int perm32(int rho) { const int n = rho >> 4, i = rho & 15; return 8 * (i >> 2) + 4 * n + (i & 3); }
struct Unit { int pm, pn; };
struct Gemm { const bf16_t* A; const bf16_t* Bt; int M, N, K, lda, a2step, rev; };
struct StaticOrder {
    int nM, nN, nwg, G, c;
    int rev;
    DI void init(int M, int N, int G_, int c_, int rev_) { nM = M / BM; nN = N / BM; nwg = nM * nN; G = G_; c = c_; rev = rev_; }
    DI bool next(int i, Unit& u) const {
        const long L = (long)i * G + c; if (L >= nwg) return false;
        int wgid = (int)L; { const int q = nwg / NXCD, r = nwg % NXCD, xcd = wgid % NXCD, off = wgid / NXCD; wgid = (xcd < r ? xcd * (q + 1) : r * (q + 1) + (xcd - r) * q) + off; }
        const int nig = WGM * nN, gid = wgid / nig, fm = gid * WGM, gsz = (nM - fm) < WGM ? (nM - fm) : WGM;
        u.pm = fm + ((wgid % nig) % gsz); u.pn = (wgid % nig) / gsz; if (rev) u.pm = nM - 1 - u.pm; return true;
    }
};

template <class Epi>
DI void gemm_phase(int wave_id, LAS unsigned char* lds, const Gemm g, const Epi& E) {
    StaticOrder S; S.init(g.M, g.N, gridDim.x, blockIdx.x, g.rev);
    const int tid = phase_tid(wave_id),
              wid = __builtin_amdgcn_readfirstlane(tid >> 6), lane = tid & 63, wr = wid >> 2, wc = wid & 3, fr = lane & 15, fq = lane >> 4;
    const int K = g.K, nt = K / BK;
    unsigned voffA[2], voffB[2];
#pragma unroll
    for (int i = 0; i < 2; ++i) { int R, C; stage_rc(tid * 16 + i * 8192, R, C); const int Rb = (R & ~31) + perm32(R & 31); voffA[i] = (unsigned)(R * g.lda + C) * 2u; voffB[i] = (unsigned)(Rb * K + C) * 2u; }
    const size_t kstep = (size_t)(BK * 2);
    const size_t hstepA = (size_t)HALF * g.lda * 2, tstepA = 2 * hstepA;
    const size_t hstepB = (size_t)HALF * K * 2, tstepB = 2 * hstepB;
    const size_t a2 = (size_t)g.a2step;
    const unsigned ldsw = (unsigned)wid * 1024u;
    const int aoff = lds_byte(wr * 64 + fr, fq * 8), boff = lds_byte(wc * 32 + fr, fq * 8);
#define PG8_SA(b, h) (((b) * 2 + (h)) * HTB)
#define PG8_SB(b, h) ((4 + (b) * 2 + (h)) * HTB)
#define PG8_STAGE(bufoff, gbase, voff) do { _Pragma("unroll") for (int _i = 0; _i < 2; ++_i) \
        __builtin_amdgcn_global_load_lds((const unsigned*)((const char*)(gbase) + (voff)[_i]), (LAS unsigned*)(lds + (bufoff) + ldsw + _i * 8192), 16, 0, 0); } while (0)
#define PG8_LDA(dst, b, h) do { _Pragma("unroll") for (int m = 0; m < 4; ++m) _Pragma("unroll") for (int k = 0; k < 2; ++k) dst[m][k] = *(const LAS bf16x8*)(lds + PG8_SA(b, h) + aoff + m * 2048 + k * 1024); } while (0)
#define PG8_LDB(dst, b, h) do { _Pragma("unroll") for (int n = 0; n < 2; ++n) _Pragma("unroll") for (int k = 0; k < 2; ++k) dst[n][k] = *(const LAS bf16x8*)(lds + PG8_SB(b, h) + boff + n * 2048 + k * 1024); } while (0)
#define PG8_MMA(ai, bj, At, Bt) do { __builtin_amdgcn_s_setprio(1); _Pragma("unroll") for (int m = 0; m < 4; ++m) _Pragma("unroll") for (int n = 0; n < 2; ++n) _Pragma("unroll") for (int k = 0; k < 2; ++k) \
        acc[ai][bj][m][n] = __builtin_amdgcn_mfma_f32_16x16x32_bf16(Bt[n][k], At[m][k], acc[ai][bj][m][n], 0, 0, 0); __builtin_amdgcn_s_setprio(0); } while (0)
#define PG8_WAIT_V(n) asm volatile("s_waitcnt vmcnt(" #n ")" ::: "memory")
#define PG8_WAIT_L(n) asm volatile("s_waitcnt lgkmcnt(" #n ")" ::: "memory")
#define PG8_BAR __builtin_amdgcn_s_barrier()
#define PG8_SCHED __builtin_amdgcn_sched_barrier(0)
    Unit cur, nxt; int ui = 0;
    if (!S.next(0, cur)) return;
    f32x4 acc[2][2][4][2];
#pragma unroll
    for (int a = 0; a < 2; ++a)
#pragma unroll
        for (int b = 0; b < 2; ++b)
#pragma unroll
            for (int m = 0; m < 4; ++m)
#pragma unroll
                for (int n = 0; n < 2; ++n) acc[a][b][m][n] = (f32x4){0.f, 0.f, 0.f, 0.f};
    bf16x8 At[4][2], B0[2][2], B1[2][2];
    const char* cA = (const char*)g.A + (size_t)cur.pm * tstepA; const char* cB = (const char*)g.Bt + (size_t)cur.pn * tstepB;
    constexpr bool SP2 = true, ALIGN_EPI = true;
    if constexpr (SP2) {
        PG8_STAGE(PG8_SB(0, 0), cB, voffB); PG8_STAGE(PG8_SB(0, 1), cB + hstepB, voffB); PG8_STAGE(PG8_SA(0, 0), cA, voffA); PG8_STAGE(PG8_SA(0, 1), cA + hstepA, voffA);
        if (wr == 1) PG8_BAR;
        PG8_WAIT_V(2); PG8_BAR;
        PG8_STAGE(PG8_SB(1, 0), cB + kstep, voffB); PG8_STAGE(PG8_SA(1, 0), cA + kstep, voffA); PG8_STAGE(PG8_SB(1, 1), cB + hstepB + kstep, voffB);
        PG8_WAIT_V(6); PG8_BAR;
    } else {
    PG8_STAGE(PG8_SB(0, 0), cB, voffB); PG8_STAGE(PG8_SA(0, 0), cA, voffA); PG8_STAGE(PG8_SB(0, 1), cB + hstepB, voffB); PG8_STAGE(PG8_SA(0, 1), cA + hstepA, voffA);
    if (wr == 1) PG8_BAR;
    PG8_WAIT_V(4); PG8_BAR;
    PG8_STAGE(PG8_SB(1, 0), cB + kstep, voffB); PG8_STAGE(PG8_SA(1, 0), cA + kstep, voffA); PG8_STAGE(PG8_SB(1, 1), cB + hstepB + kstep, voffB);
    PG8_WAIT_V(6); PG8_BAR;
    }
    for (;;) {
        const bool has_next = S.next(ui + 1, nxt);
        const char* nA = has_next ? (const char*)g.A + (size_t)nxt.pm * tstepA : cA; const char* nB = has_next ? (const char*)g.Bt + (size_t)nxt.pn * tstepB : cB;
        for (int t = 0; t < nt; t += 2) {
            const bool last = (t == nt - 2);
            const char* a1 = cA + (size_t)(t >> 1) * a2 + kstep;
            const char* a2p = last ? nA : cA + (size_t)((t >> 1) + 1) * a2; const char* b2 = last ? nB : cB + (size_t)(t + 2) * kstep;
            const char* a3 = a2p + kstep; const char* b3 = b2 + kstep;
            if constexpr (SP2) {
            PG8_LDB(B0, 0, 0); PG8_LDB(B1, 0, 1); PG8_SCHED; PG8_LDA(At, 0, 0); PG8_STAGE(PG8_SA(1, 1), a1 + hstepA, voffA);
            PG8_WAIT_V(8); PG8_WAIT_L(0); PG8_BAR; PG8_MMA(0, 0, At, B0); PG8_MMA(0, 1, At, B1); PG8_BAR; PG8_SCHED;
            PG8_LDA(At, 0, 1); PG8_STAGE(PG8_SB(0, 0), b2, voffB); PG8_STAGE(PG8_SB(0, 1), b2 + hstepB, voffB); PG8_STAGE(PG8_SA(0, 0), a2p, voffA);
            PG8_WAIT_V(8); PG8_WAIT_L(0); PG8_BAR; PG8_MMA(1, 0, At, B0); PG8_MMA(1, 1, At, B1); PG8_BAR; PG8_SCHED;
            PG8_LDB(B0, 1, 0); PG8_LDB(B1, 1, 1); PG8_SCHED; PG8_LDA(At, 1, 0); PG8_STAGE(PG8_SA(0, 1), a2p + hstepA, voffA);
            PG8_WAIT_V(8); PG8_WAIT_L(0); PG8_BAR; PG8_MMA(0, 0, At, B0); PG8_MMA(0, 1, At, B1); PG8_BAR; PG8_SCHED;
            PG8_LDA(At, 1, 1); PG8_STAGE(PG8_SB(1, 0), b3, voffB); PG8_STAGE(PG8_SB(1, 1), b3 + hstepB, voffB); PG8_STAGE(PG8_SA(1, 0), a3, voffA);
            PG8_WAIT_V(8); PG8_WAIT_L(0); PG8_BAR; PG8_MMA(1, 0, At, B0); PG8_MMA(1, 1, At, B1); PG8_BAR; PG8_SCHED;
            } else {
            PG8_LDB(B0, 0, 0); PG8_SCHED; PG8_LDA(At, 0, 0); PG8_STAGE(PG8_SA(1, 1), a1 + hstepA, voffA);
            PG8_WAIT_L(8); PG8_BAR; PG8_WAIT_L(0); PG8_MMA(0, 0, At, B0); PG8_BAR; PG8_SCHED;
            PG8_LDB(B1, 0, 1); PG8_STAGE(PG8_SB(0, 0), b2, voffB);
            PG8_BAR; PG8_WAIT_L(0); PG8_MMA(0, 1, At, B1); PG8_BAR;
            PG8_LDA(At, 0, 1); PG8_STAGE(PG8_SA(0, 0), a2p, voffA);
            PG8_BAR; PG8_WAIT_L(0); PG8_MMA(1, 0, At, B0); PG8_BAR; PG8_SCHED;
            PG8_STAGE(PG8_SB(0, 1), b2 + hstepB, voffB);
            PG8_WAIT_V(6); PG8_BAR; PG8_MMA(1, 1, At, B1); PG8_BAR;
            PG8_LDB(B0, 1, 0); PG8_SCHED; PG8_LDA(At, 1, 0); PG8_STAGE(PG8_SA(0, 1), a2p + hstepA, voffA);
            PG8_WAIT_L(8); PG8_BAR; PG8_WAIT_L(0); PG8_MMA(0, 0, At, B0); PG8_BAR; PG8_SCHED;
            PG8_LDB(B1, 1, 1); PG8_STAGE(PG8_SB(1, 0), b3, voffB);
            PG8_BAR; PG8_WAIT_L(0); PG8_MMA(0, 1, At, B1); PG8_BAR;
            PG8_LDA(At, 1, 1); PG8_STAGE(PG8_SA(1, 0), a3, voffA);
            PG8_BAR; PG8_WAIT_L(0); PG8_MMA(1, 0, At, B0); PG8_BAR; PG8_SCHED;
            PG8_STAGE(PG8_SB(1, 1), b3 + hstepB, voffB);
            PG8_WAIT_V(6); PG8_BAR; PG8_MMA(1, 1, At, B1); PG8_BAR;
            }
        }
        if constexpr (ALIGN_EPI) { if (wr == 0) PG8_BAR; }
        E(acc, cur, wr, wc, fr, fq);
        if (!has_next) break;
#pragma unroll
        for (int a = 0; a < 2; ++a)
#pragma unroll
            for (int b = 0; b < 2; ++b)
#pragma unroll
                for (int m = 0; m < 4; ++m)
#pragma unroll
                    for (int n = 0; n < 2; ++n) acc[a][b][m][n] = (f32x4){0.f, 0.f, 0.f, 0.f};
        cur = nxt; cA = nA; cB = nB; ++ui;
        if constexpr (ALIGN_EPI) { if (wr == 1) PG8_BAR; }
    }
    PG8_WAIT_V(0);
    if constexpr (!ALIGN_EPI) { if (wr == 0) PG8_BAR; }
    PG8_BAR;
#undef PG8_SA
#undef PG8_SB
#undef PG8_STAGE
#undef PG8_LDA
#undef PG8_LDB
#undef PG8_MMA
}

typedef const f32x4 (&AccRef)[2][2][4][2];
DI u32x4 pk8(const f32x4 a, const f32x4 b) { return (u32x4){pk_bf16(a[0], a[1]), pk_bf16(a[2], a[3]), pk_bf16(b[0], b[1]), pk_bf16(b[2], b[3])}; }
DI void rope4(f32x4& a, f32x4& b, const f2_t* rp) {
    const f32x4 c01 = *(const f32x4*)rp, c23 = *(const f32x4*)(rp + 2);
    const f32x4 oa = {a[0] * c01[0] - a[1] * c01[1], a[1] * c01[0] + a[0] * c01[1], a[2] * c01[2] - a[3] * c01[3], a[3] * c01[2] + a[2] * c01[3]};
    const f32x4 ob = {b[0] * c23[0] - b[1] * c23[1], b[1] * c23[0] + b[0] * c23[1], b[2] * c23[2] - b[3] * c23[3], b[3] * c23[2] + b[2] * c23[3]};
    a = oa; b = ob;
}

struct EpiHG {
    const float* ss; const float* lb; bf16_t* out;
    DI void operator()(AccRef acc, const Unit& u, int wr, int wc, int fr, int fq) const {
        const int type = u.pn >> 2;
        const int cbase = (u.pn & 3) * 256 + wc * 32 + 8 * fq;
        bf16_t* o = out + (size_t)(type == 2 ? 3 : type) * T_ * 1024;
#pragma unroll
        for (int ai = 0; ai < 2; ++ai)
#pragma unroll
            for (int m = 0; m < 4; ++m) {
                const int row = u.pm * 256 + ai * 128 + wr * 64 + m * 16 + fr;
                const float rs = rsqrtf(ss[row] * (1.0f / 1024.0f) + EPS_);
#pragma unroll
                for (int bj = 0; bj < 2; ++bj) {
                    const int col = cbase + bj * 128;
                    f32x4 v0 = acc[ai][bj][m][0] * rs, v1 = acc[ai][bj][m][1] * rs;
                    u32x4 w;
                    if (type != 1) {
#pragma unroll
                        for (int j = 0; j < 4; ++j) { v0[j] = v0[j] * sigmoidf_(v0[j]); v1[j] = v1[j] * sigmoidf_(v1[j]); }
                        w = pk8(v0, v1);
                    } else {
                        const f32x4 l0 = *(const f32x4*)(lb + col), l1 = *(const f32x4*)(lb + col + 4);
#pragma unroll
                        for (int j = 0; j < 4; ++j) { v0[j] = __logf(l0[j] + (1.0f - l0[j]) * sigmoidf_(v0[j])); v1[j] = __logf(l1[j] + (1.0f - l1[j]) * sigmoidf_(v1[j])); }
                        w = (u32x4){pk_f16(v0[0], v0[1]), pk_f16(v0[2], v0[3]), pk_f16(v1[0], v1[1]), pk_f16(v1[2], v1[3])};
                    }
                    *(u32x4*)(o + (size_t)row * 1024 + col) = w;
                }
            }
    }
};

struct EpiHVT {
    const float* ss; bf16_t* out;
    DI void operator()(AccRef acc, const Unit& u, int wr, int wc, int fr, int fq) const {
        const int cbase = u.pn * 256 + wc * 32 + 8 * fq;
#pragma unroll
        for (int bj = 0; bj < 2; ++bj) {
            const int tok = cbase + bj * 128;
            const f32x4 sa = *(const f32x4*)(ss + tok), sb = *(const f32x4*)(ss + tok + 4);
            f32x4 r0, r1;
#pragma unroll
            for (int j = 0; j < 4; ++j) { r0[j] = rsqrtf(sa[j] * (1.0f / 1024.0f) + EPS_); r1[j] = rsqrtf(sb[j] * (1.0f / 1024.0f) + EPS_); }
            const int bc = tok >> 6, s = tok & 63;
#pragma unroll
            for (int ai = 0; ai < 2; ++ai)
#pragma unroll
                for (int m = 0; m < 4; ++m) {
                    const int hv = u.pm * 256 + ai * 128 + wr * 64 + m * 16 + fr;
                    *(u32x4*)(out + ((size_t)(bc * 8 + (hv >> 7)) * 128 + (hv & 127)) * 64 + s) = pk8(acc[ai][bj][m][0] * r0, acc[ai][bj][m][1] * r1);
                }
        }
    }
};

template <bool RES_F32>
struct EpiRes {
    const void* res; bf16_t* xb; float* ss;
    DI void operator()(AccRef acc, const Unit& u, int wr, int wc, int fr, int fq) const {
        const int cbase = u.pn * 256 + wc * 32 + 8 * fq;
#pragma unroll
        for (int ai = 0; ai < 2; ++ai)
#pragma unroll
            for (int m = 0; m < 4; ++m) {
                const int row = u.pm * 256 + ai * 128 + wr * 64 + m * 16 + fr;
                float sq = 0.f;
#pragma unroll
                for (int bj = 0; bj < 2; ++bj) {
                    const size_t off = (size_t)row * 1024 + cbase + bj * 128;
                    f32x4 r0, r1;
                    if (RES_F32) { r0 = *(const f32x4*)((const float*)res + off); r1 = *(const f32x4*)((const float*)res + off + 4); }
                    else { const u32x4 rb = *(const u32x4*)((const bf16_t*)res + off);
                        r0 = (f32x4){__uint_as_float(rb.x << 16), __uint_as_float(rb.x & 0xffff0000u), __uint_as_float(rb.y << 16), __uint_as_float(rb.y & 0xffff0000u)};
                        r1 = (f32x4){__uint_as_float(rb.z << 16), __uint_as_float(rb.z & 0xffff0000u), __uint_as_float(rb.w << 16), __uint_as_float(rb.w & 0xffff0000u)}; }
                    const f32x4 v0 = acc[ai][bj][m][0] + r0, v1 = acc[ai][bj][m][1] + r1;
                    *(u32x4*)(xb + off) = pk8(v0, v1);
                    sq += ((v0[0] * v0[0] + v0[1] * v0[1]) + (v0[2] * v0[2] + v0[3] * v0[3])) + ((v1[0] * v1[0] + v1[1] * v1[1]) + (v1[2] * v1[2] + v1[3] * v1[3]));
                }
                sq += __shfl_xor(sq, 16); sq += __shfl_xor(sq, 32);
                if (fq == 0) unsafeAtomicAdd(ss + row, sq);
            }
    }
};

struct EpiRelu2 {
    const float* ss; bf16_t* out;
    DI void operator()(AccRef acc, const Unit& u, int wr, int wc, int fr, int fq) const {
        const int cbase = u.pn * 256 + wc * 32 + 8 * fq;
#pragma unroll
        for (int ai = 0; ai < 2; ++ai)
#pragma unroll
            for (int m = 0; m < 4; ++m) {
                const int row = u.pm * 256 + ai * 128 + wr * 64 + m * 16 + fr;
                const float rs = rsqrtf(ss[row] * (1.0f / 1024.0f) + EPS_);
#pragma unroll
                for (int bj = 0; bj < 2; ++bj) {
                    f32x4 v0 = acc[ai][bj][m][0] * rs, v1 = acc[ai][bj][m][1] * rs;
#pragma unroll
                    for (int j = 0; j < 4; ++j) { const float t0 = fmaxf(v0[j], 0.f), t1 = fmaxf(v1[j], 0.f); v0[j] = t0 * t0; v1[j] = t1 * t1; }
                    *(u32x4*)(out + (size_t)row * 4096 + cbase + bj * 128) = pk8(v0, v1);
                }
            }
    }
};

struct EpiDKVQ {
    const float* ss; bf16_t* ckv; bf16_t* cq; bf16_t* kr; float* ss_ckv; float* ss_cq; const f2_t* rope;
    DI void operator()(AccRef acc, const Unit& u, int wr, int wc, int fr, int fq) const {
#pragma unroll
        for (int ai = 0; ai < 2; ++ai)
#pragma unroll
            for (int m = 0; m < 4; ++m) {
                const int row = u.pm * 256 + ai * 128 + wr * 64 + m * 16 + fr;
                const float rs = rsqrtf(ss[row] * (1.0f / 1024.0f) + EPS_);
                if (u.pn < 2) {
                    bf16_t* dst = u.pn ? cq : ckv; float* sd = u.pn ? ss_cq : ss_ckv;
                    float sq = 0.f;
#pragma unroll
                    for (int bj = 0; bj < 2; ++bj) {
                        const int col = bj * 128 + wc * 32 + 8 * fq;
                        const f32x4 v0 = acc[ai][bj][m][0] * rs, v1 = acc[ai][bj][m][1] * rs;
                        *(u32x4*)(dst + (size_t)row * 256 + col) = pk8(v0, v1);
                        sq += ((v0[0] * v0[0] + v0[1] * v0[1]) + (v0[2] * v0[2] + v0[3] * v0[3])) + ((v1[0] * v1[0] + v1[1] * v1[1]) + (v1[2] * v1[2] + v1[3] * v1[3]));
                    }
                    sq += __shfl_xor(sq, 16); sq += __shfl_xor(sq, 32);
                    if (fq == 0) unsafeAtomicAdd(sd + row, sq);
                } else if (wc < 2) {
                    const int pos = row & (SEQ_ - 1);
                    const int col = wc * 32 + 8 * fq;
                    f32x4 v0 = acc[ai][0][m][0] * rs, v1 = acc[ai][0][m][1] * rs;
                    rope4(v0, v1, rope + pos * 32 + (col >> 1));
                    *(u32x4*)(kr + (size_t)row * 64 + col) = pk8(v0, v1);
                }
            }
    }
};

struct EpiKN {
    const float* ss; bf16_t* out;
    DI void operator()(AccRef acc, const Unit& u, int wr, int wc, int fr, int fq) const {
        const int cbase = u.pn * 256 + wc * 32 + 8 * fq;
#pragma unroll
        for (int ai = 0; ai < 2; ++ai)
#pragma unroll
            for (int m = 0; m < 4; ++m) {
                const int row = u.pm * 256 + ai * 128 + wr * 64 + m * 16 + fr;
                const float rs = rsqrtf(ss[row] * (1.0f / 256.0f) + EPS_);
#pragma unroll
                for (int bj = 0; bj < 2; ++bj)
                    *(u32x4*)(out + (size_t)row * 2048 + cbase + bj * 128) = pk8(acc[ai][bj][m][0] * rs, acc[ai][bj][m][1] * rs);
            }
    }
};

struct EpiVT {
    const float* ss; bf16_t* out;
    DI void operator()(AccRef acc, const Unit& u, int wr, int wc, int fr, int fq) const {
        const int cbase = u.pn * 256 + wc * 32 + 8 * fq;
#pragma unroll
        for (int bj = 0; bj < 2; ++bj)
#pragma unroll
            for (int n = 0; n < 2; ++n) {
                const int tok = cbase + bj * 128 + 4 * n;
                const f32x4 s4 = *(const f32x4*)(ss + tok);
                f32x4 rs;
#pragma unroll
                for (int j = 0; j < 4; ++j) rs[j] = rsqrtf(s4[j] * (1.0f / 256.0f) + EPS_);
                const int b = tok >> 12, s = tok & (SEQ_ - 1);
                const int ps = (s & ~12) | ((s & 4) << 1) | ((s & 8) >> 1);
#pragma unroll
                for (int ai = 0; ai < 2; ++ai)
#pragma unroll
                    for (int m = 0; m < 4; ++m) {
                        const int hv = u.pm * 256 + ai * 128 + wr * 64 + m * 16 + fr;
                        const f32x4 v = acc[ai][bj][m][n] * rs;
                        u32x2 w; w.x = pk_bf16(v[0], v[1]); w.y = pk_bf16(v[2], v[3]);
                        *(u32x2*)(out + ((size_t)(b * 2048 + hv) * SEQ_ + ps)) = w;
                    }
            }
    }
};

struct EpiQ {
    const float* ss; bf16_t* out; const f2_t* rope;
    DI void operator()(AccRef acc, const Unit& u, int wr, int wc, int fr, int fq) const {
        const int cbase = u.pn * 256 + wc * 32 + 8 * fq;
        const float QS = 0.07216878364870322f * 1.4426950408889634f;
#pragma unroll
        for (int ai = 0; ai < 2; ++ai)
#pragma unroll
            for (int m = 0; m < 4; ++m) {
                const int row = u.pm * 256 + ai * 128 + wr * 64 + m * 16 + fr;
                const float rs = rsqrtf(ss[row] * (1.0f / 256.0f) + EPS_) * QS;
                const int pos = row & (SEQ_ - 1);
#pragma unroll
                for (int bj = 0; bj < 2; ++bj) {
                    const int col = cbase + bj * 128;
                    const int d = col % 192;
                    f32x4 v0 = acc[ai][bj][m][0] * rs, v1 = acc[ai][bj][m][1] * rs;
                    if (d >= 128) rope4(v0, v1, rope + pos * 32 + ((d - 128) >> 1));
                    *(u32x4*)(out + (size_t)row * 3072 + col) = pk8(v0, v1);
                }
            }
    }
};
}

struct WJob { const float* W; const float* gain; bf16_t* dst; int ldw, coloff, K, N, ldd, mode, rowoff; };
DI int wjob_row(const WJob& j, int n) {
    if (j.mode == 0) return j.rowoff + n;
    if (j.mode == 1) return j.rowoff + ((n < 32) ? 2 * n : 2 * (n - 32) + 1);
    const int hh = n / 192, d = n - hh * 192;
    if (d < 128) return n;
    const int r = d - 128;
    return hh * 192 + 128 + ((r < 32) ? 2 * r : 2 * (r - 32) + 1);
}
DI WJob get_job(const Params& p, int j) {
    unsigned char* ws = p.ws;
    bf16_t* HG = (bf16_t*)(ws + OFF_WHG); bf16_t* DKVQ = (bf16_t*)(ws + OFF_WDKVQ); bf16_t* UKV = (bf16_t*)(ws + OFF_WUKV);
    switch (j) {
        case 0: return WJob{p.w_q, p.hgrn_norm, HG, 1024, 0, 1024, 1024, 1024, 0, 0};
        case 1: return WJob{p.w_f, p.hgrn_norm, HG, 1024, 0, 1024, 1024, 1024, 0, 1024};
        case 2: return WJob{p.w_i, p.hgrn_norm, HG, 1024, 0, 1024, 1024, 1024, 0, 3072};
        case 3: return WJob{p.w_g, p.hgrn_norm, HG, 1024, 0, 1024, 1024, 1024, 0, 2048};
        case 4: return WJob{p.w_o, nullptr, (bf16_t*)(ws + OFF_WWO), 1024, 0, 1024, 1024, 1024, 0, 0};
        case 5: return WJob{p.w_up, p.mlp_norm, (bf16_t*)(ws + OFF_WUP0), 4096, 0, 1024, 4096, 1024, 0, 0};
        case 6: return WJob{p.w_down, nullptr, (bf16_t*)(ws + OFF_WDN0), 1024, 0, 4096, 1024, 4096, 0, 0};
        case 7: return WJob{p.w_dkv, p.kv_in_norm, DKVQ, 320, 0, 1024, 256, 1024, 0, 0};
        case 8: return WJob{p.w_dkv, p.kv_in_norm, DKVQ, 320, 256, 1024, 64, 1024, 1, 512};
        case 9: return WJob{p.w_dq, p.mla_norm, DKVQ, 256, 0, 1024, 256, 1024, 0, 256};
        case 10: return WJob{p.w_uk, p.kv_norm, UKV, 2048, 0, 256, 2048, 256, 0, 0};
        case 11: return WJob{p.w_uv, p.kv_norm, UKV, 2048, 0, 256, 2048, 256, 0, 2048};
        case 12: return WJob{p.w_uq, p.q_norm, (bf16_t*)(ws + OFF_WUQ), 3072, 0, 256, 3072, 256, 2, 0};
        case 13: return WJob{p.mla_w_o, nullptr, (bf16_t*)(ws + OFF_WMWO), 1024, 0, 2048, 1024, 2048, 0, 0};
        case 14: return WJob{p.w_up + (size_t)1024 * 4096, p.mlp_norm + 1024, (bf16_t*)(ws + OFF_WUP1), 4096, 0, 1024, 4096, 1024, 0, 0};
        default: return WJob{p.w_down + (size_t)4096 * 1024, nullptr, (bf16_t*)(ws + OFF_WDN1), 1024, 0, 4096, 1024, 4096, 0, 0};
    }
}

DI void prologue_phase(int wave_id, const Params& p, LAS unsigned char* lds) {
    const int tid = phase_tid(wave_id), lane = tid & 63, wid = tid >> 6;
    const int G = gridDim.x, c = blockIdx.x;
    unsigned char* ws = p.ws;
    {
        LAS float* tileA = (LAS float*)lds;
        LAS float* tileB = (LAS float*)(lds + 16640);
        const int tx = tid & 63, ty = tid >> 6;
        constexpr int total = 6480;
        float regA[8], regB[8];
        WJob ja = get_job(p, 0), jb2 = get_job(p, 0); int ak0 = 0, an0 = 0, bk0 = 0, bn0 = 0;
#define WDECODE(g_, jb_, k0_, n0_) do { const int gg_ = (g_); \
            const int j_ = gg_ >= 5456 ? 15 : gg_ >= 4432 ? 14 : gg_ >= 3920 ? 13 : gg_ >= 3728 ? 12 : gg_ >= 3600 ? 11 : gg_ >= 3472 ? 10 : gg_ >= 3408 ? 9 : gg_ >= 3392 ? 8 : gg_ >= 3328 ? 7 : gg_ >= 2304 ? 6 : gg_ >= 1280 ? 5 : (gg_ >> 8); \
            const int base_ = gg_ >= 5456 ? 5456 : gg_ >= 4432 ? 4432 : gg_ >= 3920 ? 3920 : gg_ >= 3728 ? 3728 : gg_ >= 3600 ? 3600 : gg_ >= 3472 ? 3472 : gg_ >= 3408 ? 3408 : gg_ >= 3392 ? 3392 : gg_ >= 3328 ? 3328 : gg_ >= 2304 ? 2304 : gg_ >= 1280 ? 1280 : ((gg_ >> 8) << 8); \
            jb_ = get_job(p, j_); const int t_ = gg_ - base_; const int tn_ = jb_.N / 64; k0_ = (t_ / tn_) * 64; n0_ = (t_ % tn_) * 64; } while (0)
#define WLOAD(reg_, jb_, k0_, n0_) do { _Pragma("unroll") for (int i = 0; i < 8; ++i) { const int k = ty + 8 * i; \
            reg_[i] = jb_.W[(size_t)(k0_ + k) * jb_.ldw + jb_.coloff + n0_ + tx]; } } while (0)
#define WSTORE(tile_, oj_, ok0_, on0_, gv_) do { _Pragma("unroll") for (int i = 0; i < 8; ++i) { const int n = ty + 8 * i; \
            oj_.dst[(size_t)wjob_row(oj_, on0_ + n) * oj_.ldd + ok0_ + tx] = bf16_1(tile_[tx * 65 + n] * gv_); } } while (0)
        int g = c;
        bool haveA = g < total, haveB = g + G < total;
        if (haveA) { WDECODE(g, ja, ak0, an0); WLOAD(regA, ja, ak0, an0); }
        if (haveB) { WDECODE(g + G, jb2, bk0, bn0); WLOAD(regB, jb2, bk0, bn0); }
        while (haveA) {
#pragma unroll
            for (int i = 0; i < 8; ++i) { tileA[(ty + 8 * i) * 65 + tx] = regA[i]; if (haveB) tileB[(ty + 8 * i) * 65 + tx] = regB[i]; }
            __syncthreads();
            const WJob oa = ja, ob = jb2; const int oak0 = ak0, oan0 = an0, obk0 = bk0, obn0 = bn0; const bool hadB = haveB;
            const float gva = oa.gain ? oa.gain[oak0 + tx] : 1.0f;
            const float gvb = (hadB && ob.gain) ? ob.gain[obk0 + tx] : 1.0f;
            g += 2 * G;
            haveA = g < total; haveB = g + G < total;
            if (haveA) { WDECODE(g, ja, ak0, an0); WLOAD(regA, ja, ak0, an0); }
            if (haveB) { WDECODE(g + G, jb2, bk0, bn0); WLOAD(regB, jb2, bk0, bn0); }
            WSTORE(tileA, oa, oak0, oan0, gva);
            if (hadB) WSTORE(tileB, ob, obk0, obn0, gvb);
            __syncthreads();
        }
#undef WDECODE
#undef WLOAD
#undef WSTORE
    }
    {
        bf16_t* xb = (bf16_t*)(ws + OFF_XB0); float* ssx = (float*)(ws + OFF_SS);
        for (int row = (c * 8 + wid) * 4; row < T_; row += G * 8 * 4) {
            f32x4 v[4][4];
#pragma unroll
            for (int rr = 0; rr < 4; ++rr)
#pragma unroll
                for (int i = 0; i < 4; ++i) v[rr][i] = *((const f32x4*)(p.x + (size_t)(row + rr) * 1024) + lane + 64 * i);
#pragma unroll
            for (int rr = 0; rr < 4; ++rr) {
                float sq = 0.f;
#pragma unroll
                for (int i = 0; i < 4; ++i) {
                    const f32x4 t = v[rr][i];
                    sq += (t[0] * t[0] + t[1] * t[1]) + (t[2] * t[2] + t[3] * t[3]);
                    u32x2 w; w.x = pk_bf16(t[0], t[1]); w.y = pk_bf16(t[2], t[3]);
                    *(u32x2*)(xb + (size_t)(row + rr) * 1024 + (lane + 64 * i) * 4) = w;
                }
#pragma unroll
                for (int o = 32; o >= 1; o >>= 1) sq += __shfl_xor(sq, o);
                if (lane == 0) ssx[row + rr] = sq;
            }
        }
    }
    {
        float* ss = (float*)(ws + OFF_SS) + T_;
        for (int i = c * 512 + tid; i < 6 * T_; i += G * 512) ss[i] = 0.f;
        u32x4* pad = (u32x4*)(ws + OFF_WDKVQ + (size_t)576 * 1024 * 2);
        for (int i = c * 512 + tid; i < 192 * 1024 * 2 / 16; i += G * 512) pad[i] = (u32x4){0u, 0u, 0u, 0u};
    }
    {
        f2_t* rope = (f2_t*)(ws + OFF_ROPE);
        for (int i = c * 512 + tid; i < SEQ_ * 32; i += G * 512) {
            const int pos = i >> 5, k = i & 31;
            const float invf = exp2f(-(float)k * (13.287712379549449f / 32.0f));
            const float ang = (float)pos * invf;
            double t = (double)ang * 0.15915494309189535;
            t -= __builtin_floor(t);
            const float fr = (float)t;
            rope[i] = (f2_t){__builtin_amdgcn_cosf(fr), __builtin_amdgcn_sinf(fr)};
        }
        float* lb = (float*)(ws + OFF_LB);
        for (int i = c * 512 + tid; i < 1024; i += G * 512) lb[i] = sigmoidf_(p.lb_logits[i] - p.lb_logits[1024 + i]);
    }
}

DI f32x4 mfma16(bf16x8 a, bf16x8 b, f32x4 c) { return __builtin_amdgcn_mfma_f32_16x16x32_bf16(a, b, c, 0, 0, 0); }
DI f32x16 mfma32(bf16x8 a, bf16x8 b, f32x16 c) { return __builtin_amdgcn_mfma_f32_32x32x16_bf16(a, b, c, 0, 0, 0); }

constexpr size_t OFF_SEND = OFF_B + 156 * MiB;
constexpr size_t OFF_DSEG = OFF_B + 172 * MiB;
DI void hgrn_phase1(int wave_id, const Params& p, LAS unsigned char* lds) {
    constexpr int QT = 0, KH = 17408, OB = 0, KT = 34816, VT = 53248, ST = 71680, PM = 106496, SEG = 115712, DEC = 119808;
    const int tid = phase_tid(wave_id), lane = tid & 63, wid = __builtin_amdgcn_readfirstlane(tid >> 6), fr = lane & 15, fq = lane >> 4;
    bf16_t* HQ = (bf16_t*)(p.ws + OFF_HQ);
    const bf16_t* HGl = (const bf16_t*)(p.ws + OFF_HQ + 64 * MiB);
    const bf16_t* HVt = (const bf16_t*)(p.ws + OFF_HQ + 128 * MiB);
    bf16_t* OL = (bf16_t*)p.out;
    const int dp = lane, seg = wid;
    for (int unit = blockIdx.x; unit < 256; unit += gridDim.x) {
        const int b = unit >> 5, h = (unit >> 2) & 7, sg = unit & 3, c0 = sg * 16;
        f32x4 Sacc[8];
#pragma unroll
        for (int i = 0; i < 8; ++i) Sacc[i] = (f32x4){0.f, 0.f, 0.f, 0.f};
        for (int i = tid; i < 34816 / 16; i += 512) *(LAS u32x4*)(lds + ST + i * 16) = (u32x4){0u, 0u, 0u, 0u};
        float cum0 = 0.f, cum1 = 0.f;
        unsigned q2[8], g2[8]; u32x4 vv[2];
#define HG_LOAD(c_) do { const size_t r0_ = (size_t)b * SEQ_ + (size_t)(c_) * 64; \
            _Pragma("unroll") for (int tt = 0; tt < 8; ++tt) { const size_t idx = (r0_ + seg * 8 + tt) * 1024 + h * 128 + 2 * dp; \
                q2[tt] = *(const unsigned*)(HQ + idx); g2[tt] = *(const unsigned*)(HGl + idx); } \
            const bf16_t* vb_ = HVt + ((size_t)((b * 64 + (c_)) * 8 + h)) * 8192; \
            vv[0] = *(const u32x4*)(vb_ + tid * 8); vv[1] = *(const u32x4*)(vb_ + 4096 + tid * 8); } while (0)
        HG_LOAD(c0);
        __syncthreads();
        for (int c = c0; c < c0 + 16; ++c) {
            const size_t row0 = (size_t)b * SEQ_ + (size_t)c * 64;
            float g[8][2], q[8][2], kk[8][2];
            float run0 = 0.f, run1 = 0.f;
#pragma unroll
            for (int tt = 0; tt < 8; ++tt) {
                const h2_t gh = __builtin_bit_cast(h2_t, g2[tt]);
                const float g0 = (float)gh[0], g1 = (float)gh[1];
                q[tt][0] = __uint_as_float(q2[tt] << 16); q[tt][1] = __uint_as_float(q2[tt] & 0xffff0000u);
                kk[tt][0] = 1.0f - fast_exp(g0); kk[tt][1] = 1.0f - fast_exp(g1);
                run0 += g0; run1 += g1; g[tt][0] = run0; g[tt][1] = run1;
            }
            *(LAS u32x4*)(lds + VT + ((tid >> 3) * 72 + (tid & 7) * 8) * 2) = vv[0];
            *(LAS u32x4*)(lds + VT + ((64 + (tid >> 3)) * 72 + (tid & 7) * 8) * 2) = vv[1];
            *(LAS f2_t*)(lds + SEG + (seg * 128 + 2 * dp) * 4) = (f2_t){run0, run1};
            __syncthreads();
            float off0 = 0.f, off1 = 0.f, tot0 = 0.f, tot1 = 0.f;
#pragma unroll
            for (int s8 = 0; s8 < 8; ++s8) { const f2_t xx = *(const LAS f2_t*)(lds + SEG + (s8 * 128 + 2 * dp) * 4); if (s8 < seg) { off0 += xx.x; off1 += xx.y; } tot0 += xx.x; tot1 += xx.y; }
            if (seg == 0) *(LAS f2_t*)(lds + DEC + 2 * dp * 4) = (f2_t){fast_exp(tot0), fast_exp(tot1)};
            const float ec0 = fast_exp(cum0), ec1 = fast_exp(cum1);
            float kt0[8], kt1[8];
#pragma unroll
            for (int tt = 0; tt < 8; ++tt) {
                const float b0 = off0 + g[tt][0], b1 = off1 + g[tt][1];
                const int t = seg * 8 + tt;
                const float qa = q[tt][0] * fast_exp(b0), qb_ = q[tt][1] * fast_exp(b1);
                *(LAS unsigned*)(lds + QT + (t * 136 + 2 * dp) * 2) = pk_bf16(qa, qb_);
                if (sg > 0) *(unsigned*)(HQ + (row0 + t) * 1024 + h * 128 + 2 * dp) = pk_bf16(qa * ec0, qb_ * ec1);
                *(LAS unsigned*)(lds + KH + (t * 136 + 2 * dp) * 2) = pk_bf16(kk[tt][0] * fast_exp(-b0), kk[tt][1] * fast_exp(-b1));
                kt0[tt] = kk[tt][0] * fast_exp(tot0 - b0); kt1[tt] = kk[tt][1] * fast_exp(tot1 - b1);
            }
            cum0 += tot0; cum1 += tot1;
            *(LAS u32x4*)(lds + KT + ((2 * dp) * 72 + seg * 8) * 2) = (u32x4){pk_bf16(kt0[0], kt0[1]), pk_bf16(kt0[2], kt0[3]), pk_bf16(kt0[4], kt0[5]), pk_bf16(kt0[6], kt0[7])};
            *(LAS u32x4*)(lds + KT + ((2 * dp + 1) * 72 + seg * 8) * 2) = (u32x4){pk_bf16(kt1[0], kt1[1]), pk_bf16(kt1[2], kt1[3]), pk_bf16(kt1[4], kt1[5]), pk_bf16(kt1[6], kt1[7])};
            __syncthreads();
            if (c + 1 < c0 + 16) HG_LOAD(c + 1);
#pragma unroll
            for (int ii = 0; ii < 2; ++ii) {
                const int idx = wid + 8 * ii, st = idx >> 2, tt = idx & 3;
                f32x4 a = (f32x4){0.f, 0.f, 0.f, 0.f};
                if (st <= tt) {
#pragma unroll
                    for (int ks = 0; ks < 4; ++ks) {
                        const bf16x8 ka = *(const LAS bf16x8*)(lds + KH + ((st * 16 + fr) * 136 + ks * 32 + fq * 8) * 2);
                        const bf16x8 qb = *(const LAS bf16x8*)(lds + QT + ((tt * 16 + fr) * 136 + ks * 32 + fq * 8) * 2);
                        a = mfma16(ka, qb, a);
                    }
                    if (st == tt) {
#pragma unroll
                        for (int j = 0; j < 4; ++j) if (fq * 4 + j > fr) a[j] = 0.f;
                    }
                }
                u32x2 w; w.x = pk_bf16(a[0], a[1]); w.y = pk_bf16(a[2], a[3]);
                *(LAS u32x2*)(lds + PM + ((tt * 16 + fr) * 72 + st * 16 + fq * 4) * 2) = w;
            }
            __syncthreads();
            const int ott = wid & 3, ovb = (wid >> 2) * 4;
            f32x4 oacc[4];
#pragma unroll
            for (int vi = 0; vi < 4; ++vi) {
                const int vt = ovb + vi;
                f32x4 a = (f32x4){0.f, 0.f, 0.f, 0.f};
#pragma unroll
                for (int ks = 0; ks < 4; ++ks) {
                    const bf16x8 sa = *(const LAS bf16x8*)(lds + ST + ((vt * 16 + fr) * 136 + ks * 32 + fq * 8) * 2);
                    const bf16x8 qb = *(const LAS bf16x8*)(lds + QT + ((ott * 16 + fr) * 136 + ks * 32 + fq * 8) * 2);
                    a = mfma16(sa, qb, a);
                }
#pragma unroll
                for (int ks = 0; ks < 2; ++ks) {
                    const bf16x8 va = *(const LAS bf16x8*)(lds + VT + ((vt * 16 + fr) * 72 + ks * 32 + fq * 8) * 2);
                    const bf16x8 pb = *(const LAS bf16x8*)(lds + PM + ((ott * 16 + fr) * 72 + ks * 32 + fq * 8) * 2);
                    a = mfma16(va, pb, a);
                }
                oacc[vi] = a;
            }
            {
                const f32x4 dec4 = *(const LAS f32x4*)(lds + DEC + (wid * 16 + fq * 4) * 4);
                bf16x8 ka[2];
#pragma unroll
                for (int ks = 0; ks < 2; ++ks) ka[ks] = *(const LAS bf16x8*)(lds + KT + ((wid * 16 + fr) * 72 + ks * 32 + fq * 8) * 2);
#pragma unroll
                for (int vt = 0; vt < 8; ++vt) {
                    f32x4 a = Sacc[vt] * dec4;
#pragma unroll
                    for (int ks = 0; ks < 2; ++ks) {
                        const bf16x8 vb = *(const LAS bf16x8*)(lds + VT + ((vt * 16 + fr) * 72 + ks * 32 + fq * 8) * 2);
                        a = mfma16(ka[ks], vb, a);
                    }
                    Sacc[vt] = a;
                }
            }
#pragma unroll
            for (int vi = 0; vi < 4; ++vi) { u32x2 w; w.x = pk_bf16(oacc[vi][0], oacc[vi][1]); w.y = pk_bf16(oacc[vi][2], oacc[vi][3]); *(u32x2*)(OL + (row0 + ott * 16 + fr) * 1024 + h * 128 + (ovb + vi) * 16 + fq * 4) = w; }
            __syncthreads();
#pragma unroll
            for (int vt = 0; vt < 8; ++vt) {
                u32x2 w; w.x = pk_bf16(Sacc[vt][0], Sacc[vt][1]); w.y = pk_bf16(Sacc[vt][2], Sacc[vt][3]);
                *(LAS u32x2*)(lds + ST + ((vt * 16 + fr) * 136 + wid * 16 + fq * 4) * 2) = w;
            }
        }
        float* send = (float*)(p.ws + OFF_SEND) + (size_t)unit * 16384;
#pragma unroll
        for (int vt = 0; vt < 8; ++vt)
#pragma unroll
            for (int j = 0; j < 4; ++j) send[(wid * 16 + fq * 4 + j) * 128 + vt * 16 + fr] = Sacc[vt][j];
        if (seg == 0) *(f2_t*)((float*)(p.ws + OFF_DSEG) + unit * 128 + 2 * dp) = (f2_t){fast_exp(cum0), fast_exp(cum1)};
        __syncthreads();
    }
#undef HG_LOAD
}

DI void hgrn_phase2(int wave_id, const Params& p, LAS unsigned char* lds) {
    constexpr int QT = 0, OB = 34816, ST = 71680;
    const int tid = phase_tid(wave_id), lane = tid & 63, wid = __builtin_amdgcn_readfirstlane(tid >> 6), fr = lane & 15, fq = lane >> 4;
    const bf16_t* HQ = (const bf16_t*)(p.ws + OFF_HQ);
    const bf16_t* HGt = (const bf16_t*)(p.ws + OFF_HQ + 192 * MiB);
    const bf16_t* OL = (const bf16_t*)p.out;
    bf16_t* OG = (bf16_t*)(p.ws + OFF_OG);
    const int er = tid >> 3, ep = tid & 7;
    for (int unit = blockIdx.x; unit < 256; unit += gridDim.x) {
        const int b = unit >> 5, h = (unit >> 2) & 7, sg = unit & 3, c0 = sg * 16;
        {
            const float* send = (const float*)(p.ws + OFF_SEND) + (size_t)(unit - sg) * 16384;
            const float* dsg = (const float*)(p.ws + OFF_DSEG) + (unit - sg) * 128;
#pragma unroll
            for (int i0 = 0; i0 < 32; i0 += 8) {
                float sv[8][3], dv[8][3];
#pragma unroll
                for (int i = 0; i < 8; ++i) {
                    const int e = tid + 512 * (i0 + i), d = e >> 7;
#pragma unroll
                    for (int s2 = 0; s2 < 3; ++s2) { sv[i][s2] = send[(size_t)s2 * 16384 + e]; dv[i][s2] = dsg[s2 * 128 + d]; }
                }
#pragma unroll
                for (int i = 0; i < 8; ++i) {
                    const int e = tid + 512 * (i0 + i), d = e >> 7, v = e & 127;
                    float S = 0.f;
#pragma unroll
                    for (int s2 = 0; s2 < 3; ++s2) { const bool on = s2 < sg; S = (on ? dv[i][s2] : 1.f) * S + (on ? sv[i][s2] : 0.f); }
                    *(LAS bf16_t*)(lds + ST + (v * 136 + d) * 2) = bf16_1(S);
                }
            }
        }
        u32x4 qv[2] = {(u32x4){0u, 0u, 0u, 0u}, (u32x4){0u, 0u, 0u, 0u}};
        if (sg > 0) {
            qv[0] = *(const u32x4*)(HQ + ((size_t)b * SEQ_ + (size_t)c0 * 64 + (tid >> 4)) * 1024 + h * 128 + (tid & 15) * 8);
            qv[1] = *(const u32x4*)(HQ + ((size_t)b * SEQ_ + (size_t)c0 * 64 + 32 + (tid >> 4)) * 1024 + h * 128 + (tid & 15) * 8);
        }
        for (int c = c0; c < c0 + 16; ++c) {
            const size_t row0 = (size_t)b * SEQ_ + (size_t)c * 64;
            *(LAS u32x4*)(lds + QT + ((tid >> 4) * 136 + (tid & 15) * 8) * 2) = qv[0];
            *(LAS u32x4*)(lds + QT + ((32 + (tid >> 4)) * 136 + (tid & 15) * 8) * 2) = qv[1];
            f32x4 ol[4];
            {
                const u32x4 oa = *(const u32x4*)(OL + (row0 + er) * 1024 + h * 128 + ep * 16), ob = *(const u32x4*)(OL + (row0 + er) * 1024 + h * 128 + ep * 16 + 8);
                ol[0] = (f32x4){__uint_as_float(oa.x << 16), __uint_as_float(oa.x & 0xffff0000u), __uint_as_float(oa.y << 16), __uint_as_float(oa.y & 0xffff0000u)};
                ol[1] = (f32x4){__uint_as_float(oa.z << 16), __uint_as_float(oa.z & 0xffff0000u), __uint_as_float(oa.w << 16), __uint_as_float(oa.w & 0xffff0000u)};
                ol[2] = (f32x4){__uint_as_float(ob.x << 16), __uint_as_float(ob.x & 0xffff0000u), __uint_as_float(ob.y << 16), __uint_as_float(ob.y & 0xffff0000u)};
                ol[3] = (f32x4){__uint_as_float(ob.z << 16), __uint_as_float(ob.z & 0xffff0000u), __uint_as_float(ob.w << 16), __uint_as_float(ob.w & 0xffff0000u)};
            }
            const bf16x8 gt0 = *(const bf16x8*)(HGt + (row0 + er) * 1024 + h * 128 + ep * 16);
            const bf16x8 gt1 = *(const bf16x8*)(HGt + (row0 + er) * 1024 + h * 128 + ep * 16 + 8);
            __syncthreads();
            if (sg > 0 && c + 1 < c0 + 16) {
                qv[0] = *(const u32x4*)(HQ + (row0 + 64 + (tid >> 4)) * 1024 + h * 128 + (tid & 15) * 8);
                qv[1] = *(const u32x4*)(HQ + (row0 + 64 + 32 + (tid >> 4)) * 1024 + h * 128 + (tid & 15) * 8);
            }
            const int ott = wid & 3, ovb = (wid >> 2) * 4;
#pragma unroll
            for (int vi = 0; vi < 4; ++vi) {
                const int vt = ovb + vi;
                f32x4 a = (f32x4){0.f, 0.f, 0.f, 0.f};
                if (sg > 0) {
#pragma unroll
                    for (int ks = 0; ks < 4; ++ks) {
                        const bf16x8 sa = *(const LAS bf16x8*)(lds + ST + ((vt * 16 + fr) * 136 + ks * 32 + fq * 8) * 2);
                        const bf16x8 qb = *(const LAS bf16x8*)(lds + QT + ((ott * 16 + fr) * 136 + ks * 32 + fq * 8) * 2);
                        a = mfma16(sa, qb, a);
                    }
                }
                *(LAS f32x4*)(lds + OB + ((ott * 16 + fr) * 132 + vt * 16 + fq * 4) * 4) = a;
            }
            __syncthreads();
            {
                f32x4 ov[4]; float sq = 0.f;
#pragma unroll
                for (int i = 0; i < 4; ++i) { ov[i] = *(const LAS f32x4*)(lds + OB + (er * 132 + ep * 16 + i * 4) * 4) + ol[i]; sq += (ov[i][0] * ov[i][0] + ov[i][1] * ov[i][1]) + (ov[i][2] * ov[i][2] + ov[i][3] * ov[i][3]); }
                sq += __shfl_xor(sq, 1); sq += __shfl_xor(sq, 2); sq += __shfl_xor(sq, 4);
                const float sc = rsqrtf(sq * (1.0f / 128.0f) + EPS_);
                unsigned w[8];
#pragma unroll
                for (int i = 0; i < 4; ++i) {
                    const f32x4 gn = *(const f32x4*)(p.g_norm + ep * 16 + i * 4);
                    float r[4];
#pragma unroll
                    for (int j = 0; j < 4; ++j) {
                        const int e = i * 4 + j;
                        const float gate = bf2f((unsigned short)(e < 8 ? gt0[e] : gt1[e - 8]));
                        r[j] = ov[i][j] * sc * gn[j] * gate;
                    }
                    w[i * 2] = pk_bf16(r[0], r[1]); w[i * 2 + 1] = pk_bf16(r[2], r[3]);
                }
                bf16_t* op = OG + (row0 + er) * 1024 + h * 128 + ep * 16;
                *(u32x4*)op = (u32x4){w[0], w[1], w[2], w[3]};
                *(u32x4*)(op + 8) = (u32x4){w[4], w[5], w[6], w[7]};
            }
        }
        __syncthreads();
    }
}

struct AttU { int b, h, qb; };
DI void attn_unit(int wave_id, const bf16_t* Q, const bf16_t* KN, const bf16_t* KR, const bf16_t* VTg, bf16_t* O, const AttU u, const AttU nu, bool has_next,
                  bf16x8 (&qf)[12], u32x4 (&stg)[5], LAS unsigned char* lds) {
    constexpr int KSTR = 400, VSTR = 144, KBYTES = 64 * KSTR, STAGE = KBYTES + 128 * VSTR;
    const int tid = phase_tid(wave_id), lane = tid & 63, wid = __builtin_amdgcn_readfirstlane(tid >> 6), r = lane & 31, hh = lane >> 5;
    const int b = u.b, h = u.h, qb = u.qb;
    const int q0 = qb * 256 + wid * 32;
    f32x16 o[4];
#pragma unroll
    for (int i = 0; i < 4; ++i)
#pragma unroll
        for (int j = 0; j < 16; ++j) o[i][j] = 0.f;
    float m_run = -1e30f, l_run = 0.f;
    const int ntiles = 4 * qb + 4;
    const char* gKN = (const char*)(KN + (size_t)(b * SEQ_) * 2048 + h * 128);
    const char* gKR = (const char*)(KR + (size_t)(b * SEQ_) * 64);
    const char* gVT = (const char*)(VTg + (size_t)(b * 2048 + h * 128) * SEQ_);
    const unsigned gn0 = (unsigned)(((tid >> 4) * 2048 + (tid & 15) * 8) * 2), ln0 = (unsigned)((tid >> 4) * KSTR + (tid & 15) * 16);
    const unsigned gr0 = (unsigned)(tid * 16), lr0 = (unsigned)((tid >> 3) * KSTR + 256 + (tid & 7) * 16);
    const unsigned gv0 = (unsigned)(((tid >> 3) * SEQ_ + (tid & 7) * 8) * 2), lv0 = (unsigned)(KBYTES + (tid >> 3) * VSTR + (tid & 7) * 16);
#define ATT_LOADP(pKN_, pKR_, pVT_, kt_) do { \
        stg[0] = *(const u32x4*)((pKN_) + (size_t)(kt_) * (64 * 2048 * 2) + gn0); \
        stg[1] = *(const u32x4*)((pKN_) + (size_t)(kt_) * (64 * 2048 * 2) + 32 * 2048 * 2 + gn0); \
        stg[2] = *(const u32x4*)((pKR_) + (size_t)(kt_) * (64 * 64 * 2) + gr0); \
        stg[3] = *(const u32x4*)((pVT_) + (size_t)(kt_) * 128 + gv0); \
        stg[4] = *(const u32x4*)((pVT_) + (size_t)(kt_) * 128 + 64 * SEQ_ * 2 + gv0); } while (0)
#define ATT_LOAD(kt_) ATT_LOADP(gKN, gKR, gVT, kt_)
#define ATT_STORE(buf_) do { \
        *(LAS u32x4*)(lds + (buf_) + ln0) = stg[0]; *(LAS u32x4*)(lds + (buf_) + 32 * KSTR + ln0) = stg[1]; \
        *(LAS u32x4*)(lds + (buf_) + lr0) = stg[2]; \
        *(LAS u32x4*)(lds + (buf_) + lv0) = stg[3]; *(LAS u32x4*)(lds + (buf_) + 64 * VSTR + lv0) = stg[4]; } while (0)
    ATT_STORE(0);
    if (ntiles > 1) ATT_LOAD(1);
    __syncthreads();
    for (int kt = 0; kt < ntiles; ++kt) {
        const int cur = (kt & 1) * STAGE, nxt = ((kt + 1) & 1) * STAGE;
        const bool more = (kt + 1 < ntiles);
        __builtin_amdgcn_s_setprio(1);
        const int key0 = kt * 64;
        if (key0 <= q0 + 31) {
            const bool act1 = (key0 + 32 <= q0 + 31);
            f32x16 s0, s1;
#pragma unroll
            for (int j = 0; j < 16; ++j) { s0[j] = 0.f; s1[j] = 0.f; }
            const unsigned kb0 = cur + r * KSTR + 16 * hh, kb1 = kb0 + 32 * KSTR;
            if (act1) {
                bf16x8 ka[3], kc[3];
#pragma unroll
                for (int i = 0; i < 3; ++i) { ka[i] = *(const LAS bf16x8*)(lds + kb0 + 32 * i); kc[i] = *(const LAS bf16x8*)(lds + kb1 + 32 * i); }
#pragma unroll
                for (int ks = 0; ks < 12; ++ks) {
                    s0 = mfma32(ka[ks % 3], qf[ks], s0);
                    s1 = mfma32(kc[ks % 3], qf[ks], s1);
                    if (ks + 3 < 12) { ka[ks % 3] = *(const LAS bf16x8*)(lds + kb0 + 32 * (ks + 3)); kc[ks % 3] = *(const LAS bf16x8*)(lds + kb1 + 32 * (ks + 3)); }
                }
            } else {
                bf16x8 ka[4];
#pragma unroll
                for (int i = 0; i < 4; ++i) ka[i] = *(const LAS bf16x8*)(lds + kb0 + 32 * i);
#pragma unroll
                for (int ks = 0; ks < 12; ++ks) {
                    s0 = mfma32(ka[ks & 3], qf[ks], s0);
                    if (ks + 4 < 12) ka[ks & 3] = *(const LAS bf16x8*)(lds + kb0 + 32 * (ks + 4));
                }
            }
            const int qpos = q0 + r;
            if (key0 + 63 > q0) {
#pragma unroll
                for (int j = 0; j < 16; ++j) {
                    const int kr = (j & 3) + 8 * (j >> 2) + 4 * hh;
                    if (key0 + kr > qpos) s0[j] = -INFINITY;
                    if (!act1 || key0 + 32 + kr > qpos) s1[j] = -INFINITY;
                }
            }
            float mx = s0[0];
#pragma unroll
            for (int j = 1; j < 16; ++j) mx = fmaxf(mx, s0[j]);
#pragma unroll
            for (int j = 0; j < 16; ++j) mx = fmaxf(mx, s1[j]);
            { const u32x2 sw = __builtin_amdgcn_permlane32_swap(__float_as_uint(mx), __float_as_uint(mx), false, false);
              mx = fmaxf(__uint_as_float(sw.x), __uint_as_float(sw.y)); }
            const float m_new = fmaxf(m_run, mx);
            const bool grow = __builtin_amdgcn_ballot_w64(m_new > m_run) != 0ull;
            const float alpha = __builtin_amdgcn_exp2f(m_run - m_new);
            m_run = m_new;
            float rs = 0.f;
#pragma unroll
            for (int j = 0; j < 16; ++j) { s0[j] = __builtin_amdgcn_exp2f(s0[j] - m_new); rs += s0[j]; }
#pragma unroll
            for (int j = 0; j < 16; ++j) { s1[j] = __builtin_amdgcn_exp2f(s1[j] - m_new); rs += s1[j]; }
            if (grow) {
                l_run *= alpha;
#pragma unroll
                for (int i = 0; i < 4; ++i)
#pragma unroll
                    for (int j = 0; j < 16; ++j) o[i][j] *= alpha;
            }
            l_run += rs;
#pragma unroll
            for (int s2 = 0; s2 < 2; ++s2) {
                u32x4 pw;
                pw.x = pk_bf16(s0[8 * s2 + 0], s0[8 * s2 + 1]); pw.y = pk_bf16(s0[8 * s2 + 2], s0[8 * s2 + 3]);
                pw.z = pk_bf16(s0[8 * s2 + 4], s0[8 * s2 + 5]); pw.w = pk_bf16(s0[8 * s2 + 6], s0[8 * s2 + 7]);
                const bf16x8 pb = __builtin_bit_cast(bf16x8, pw);
#pragma unroll
                for (int vt = 0; vt < 4; ++vt) {
                    const bf16x8 vf = *(const LAS bf16x8*)(lds + cur + KBYTES + (32 * vt + r) * VSTR + (16 * s2 + 8 * hh) * 2);
                    o[vt] = mfma32(vf, pb, o[vt]);
                }
            }
            if (act1) {
#pragma unroll
                for (int s2 = 0; s2 < 2; ++s2) {
                    u32x4 pw;
                    pw.x = pk_bf16(s1[8 * s2 + 0], s1[8 * s2 + 1]); pw.y = pk_bf16(s1[8 * s2 + 2], s1[8 * s2 + 3]);
                    pw.z = pk_bf16(s1[8 * s2 + 4], s1[8 * s2 + 5]); pw.w = pk_bf16(s1[8 * s2 + 6], s1[8 * s2 + 7]);
                    const bf16x8 pb = __builtin_bit_cast(bf16x8, pw);
#pragma unroll
                    for (int vt = 0; vt < 4; ++vt) {
                        const bf16x8 vf = *(const LAS bf16x8*)(lds + cur + KBYTES + (32 * vt + r) * VSTR + (32 + 16 * s2 + 8 * hh) * 2);
                        o[vt] = mfma32(vf, pb, o[vt]);
                    }
                }
            }
        }
        __builtin_amdgcn_s_setprio(0);
        if (more) ATT_STORE(nxt);
        __builtin_amdgcn_s_setprio(1);
        if (kt + 2 < ntiles) ATT_LOAD(kt + 2);
        __syncthreads();
    }
    __builtin_amdgcn_s_setprio(0);
    if (has_next) {
        const bf16_t* qp = Q + ((size_t)(nu.b * SEQ_ + nu.qb * 256 + wid * 32 + r) * 3072 + nu.h * 192 + 8 * hh);
#pragma unroll
        for (int ks = 0; ks < 12; ++ks) qf[ks] = *(const bf16x8*)(qp + 16 * ks);
        const char* nKN = (const char*)(KN + (size_t)(nu.b * SEQ_) * 2048 + nu.h * 128);
        const char* nKR = (const char*)(KR + (size_t)(nu.b * SEQ_) * 64);
        const char* nVT = (const char*)(VTg + (size_t)(nu.b * 2048 + nu.h * 128) * SEQ_);
        ATT_LOADP(nKN, nKR, nVT, 0);
    }
    const u32x2 lsw = __builtin_amdgcn_permlane32_swap(__float_as_uint(l_run), __float_as_uint(l_run), false, false);
    const float lt = __uint_as_float(lsw.x) + __uint_as_float(lsw.y);
    const float inv = 1.0f / lt;
    bf16_t* op = O + ((size_t)(b * SEQ_ + q0 + r) * 3072 + h * 192);
#pragma unroll
    for (int vt = 0; vt < 4; ++vt)
#pragma unroll
        for (int gq = 0; gq < 4; ++gq) {
            u32x2 w; w.x = pk_bf16(o[vt][4 * gq] * inv, o[vt][4 * gq + 1] * inv); w.y = pk_bf16(o[vt][4 * gq + 2] * inv, o[vt][4 * gq + 3] * inv);
            *(u32x2*)(op + 32 * vt + 8 * gq + 4 * hh) = w;
        }
#undef ATT_LOAD
#undef ATT_LOADP
#undef ATT_STORE
}

DI AttU attn_sched(int i) {
    const int b = blockIdx.x & 7, j = blockIdx.x >> 3;
    return AttU{b, 2 * i + (j >> 4), (i & 1) ? (j & 15) : 15 - (j & 15)};
}

DI void attn_phase(int wave_id, const Params& p, LAS unsigned char* lds) {
    const bf16_t* Q = (const bf16_t*)(p.ws + OFF_Q);
    const bf16_t* KN = (const bf16_t*)(p.ws + OFF_KN);
    const bf16_t* KR = (const bf16_t*)(p.ws + OFF_KR);
    const bf16_t* VTg = (const bf16_t*)(p.ws + OFF_VT);
    bf16_t* O = (bf16_t*)(p.ws + OFF_Q);
    const int tid = phase_tid(wave_id), lane = tid & 63, wid = __builtin_amdgcn_readfirstlane(tid >> 6), r = lane & 31, hh = lane >> 5;
    bf16x8 qf[12]; u32x4 stg[5];
    const bool sched256 = gridDim.x == 256;
    const int nunits = sched256 ? 8 : (2048 - (int)blockIdx.x + (int)gridDim.x - 1) / (int)gridDim.x;
#define ATT_UNIT_OF(i_) (sched256 ? attn_sched(i_) : AttU{(int)((blockIdx.x + (i_) * gridDim.x) & 7), (int)(((blockIdx.x + (i_) * gridDim.x) >> 3) & 15), (int)((blockIdx.x + (i_) * gridDim.x) >> 7)})
    if (nunits > 0) {
        const AttU u0 = ATT_UNIT_OF(0);
        const bf16_t* qp = Q + ((size_t)(u0.b * SEQ_ + u0.qb * 256 + wid * 32 + r) * 3072 + u0.h * 192 + 8 * hh);
#pragma unroll
        for (int ks = 0; ks < 12; ++ks) qf[ks] = *(const bf16x8*)(qp + 16 * ks);
        const char* nKN = (const char*)(KN + (size_t)(u0.b * SEQ_) * 2048 + u0.h * 128);
        const char* nKR = (const char*)(KR + (size_t)(u0.b * SEQ_) * 64);
        const char* nVT = (const char*)(VTg + (size_t)(u0.b * 2048 + u0.h * 128) * SEQ_);
        stg[0] = *(const u32x4*)(nKN + (unsigned)(((tid >> 4) * 2048 + (tid & 15) * 8) * 2));
        stg[1] = *(const u32x4*)(nKN + 32 * 2048 * 2 + (unsigned)(((tid >> 4) * 2048 + (tid & 15) * 8) * 2));
        stg[2] = *(const u32x4*)(nKR + (unsigned)(tid * 16));
        stg[3] = *(const u32x4*)(nVT + (unsigned)(((tid >> 3) * SEQ_ + (tid & 7) * 8) * 2));
        stg[4] = *(const u32x4*)(nVT + 64 * SEQ_ * 2 + (unsigned)(((tid >> 3) * SEQ_ + (tid & 7) * 8) * 2));
    }
    for (int i = 0; i < nunits; ++i)
        attn_unit(wave_id, Q, KN, KR, VTg, O, ATT_UNIT_OF(i), ATT_UNIT_OF(i + 1 < nunits ? i + 1 : i), i + 1 < nunits, qf, stg, lds);
#undef ATT_UNIT_OF
}

DI void final_phase(int wave_id, const Params& p) {
    const int tid = phase_tid(wave_id), lane = tid & 63, wid = tid >> 6;
    const float* ss = (const float*)(p.ws + OFF_SS) + 4 * (size_t)T_;
    const bf16_t* hb = (const bf16_t*)(p.ws + OFF_XB3);
    for (int row = blockIdx.x * 8 + wid; row < T_; row += gridDim.x * 8) {
        const float rs = rsqrtf(ss[row] * (1.0f / 1024.0f) + EPS_);
        f32x4* orow = (f32x4*)(p.out + (size_t)row * 1024);
#pragma unroll
        for (int i = 0; i < 2; ++i) {
            const int c8 = lane + 64 * i;
            const u32x4 hv = *(const u32x4*)(hb + (size_t)row * 1024 + c8 * 8);
            const f32x4 g0 = *(const f32x4*)(p.final_norm + c8 * 8), g1 = *(const f32x4*)(p.final_norm + c8 * 8 + 4);
            orow[c8 * 2] = (f32x4){__uint_as_float(hv.x << 16), __uint_as_float(hv.x & 0xffff0000u), __uint_as_float(hv.y << 16), __uint_as_float(hv.y & 0xffff0000u)} * rs * g0;
            orow[c8 * 2 + 1] = (f32x4){__uint_as_float(hv.z << 16), __uint_as_float(hv.z & 0xffff0000u), __uint_as_float(hv.w << 16), __uint_as_float(hv.w & 0xffff0000u)} * rs * g1;
        }
    }
}

__global__ void __launch_bounds__(512) fwd_megakernel(Params p) {
    extern __shared__ __attribute__((aligned(16))) unsigned char lds_raw[];
    LAS unsigned char* lds = (LAS unsigned char*)lds_raw;
    cg::grid_group grid = cg::this_grid();
    const int wave_id = __builtin_amdgcn_readfirstlane(threadIdx.x >> 6);
    using namespace pg8;
    {
        const int t0 = phase_tid(wave_id);
        if (t0 == 0) { *(LAS u32x4*)(lds + 131072) = (u32x4){0u, 0u, 0u, 0u}; }
        __syncthreads();
    }
    const XcdBarrier xb = xcd_barrier_post((unsigned*)(p.ws + OFF_BAR), (volatile LAS unsigned*)(lds + 131072), phase_tid(wave_id));
#ifndef PHASE_MASK
#define PHASE_MASK 0xffff
#endif
#define PH(i) if ((PHASE_MASK >> (i)) & 1)
#define WSDEF unsigned char* ws = p.ws; asm volatile("" : "+s"(ws)); float* SS = (float*)(ws + OFF_SS); \
    float *ss_x = SS, *ss_h1 = SS + T_, *ss_h2 = SS + 2 * T_, *ss_h3 = SS + 3 * T_, *ss_h4 = SS + 4 * T_, *ss_ckv = SS + 5 * T_, *ss_cq = SS + 6 * T_; \
    bf16_t* XB0 = (bf16_t*)(ws + OFF_XB0); const f2_t* rope = (const f2_t*)(ws + OFF_ROPE); \
    (void)ss_x; (void)ss_h1; (void)ss_h2; (void)ss_h3; (void)ss_h4; (void)ss_ckv; (void)ss_cq; (void)XB0; (void)rope;
    PH(0) prologue_phase(wave_id, p, lds);
    if (p.ws == nullptr) grid.sync();
    xcd_barrier(xb, phase_tid(wave_id));
    PH(1) { WSDEF gemm_phase(wave_id, lds, Gemm{XB0, (const bf16_t*)(ws + OFF_WHG), T_, 3072, 1024, 1024, 256, 0}, EpiHG{ss_x, (const float*)(ws + OFF_LB), (bf16_t*)(ws + OFF_HQ)}); }
    PH(1) { WSDEF gemm_phase(wave_id, lds, Gemm{(const bf16_t*)(ws + OFF_WHG) + (size_t)3072 * 1024, XB0, 1024, T_, 1024, 1024, 256, 0}, EpiHVT{ss_x, (bf16_t*)(ws + OFF_HQ + 128 * MiB)}); }
    xcd_barrier(xb, phase_tid(wave_id));
    PH(2) hgrn_phase1(wave_id, p, lds);
    xcd_barrier(xb, phase_tid(wave_id));
    PH(2) hgrn_phase2(wave_id, p, lds);
    xcd_barrier(xb, phase_tid(wave_id));
    PH(3) { WSDEF gemm_phase(wave_id, lds, Gemm{(const bf16_t*)(ws + OFF_OG), (const bf16_t*)(ws + OFF_WWO), T_, 1024, 1024, 1024, 256, 0}, EpiRes<false>{XB0, XB0, ss_h1}); }
    xcd_barrier(xb, phase_tid(wave_id));
    PH(4) { WSDEF gemm_phase(wave_id, lds, Gemm{XB0, (const bf16_t*)(ws + OFF_WUP0), T_, 4096, 1024, 1024, 256, 0}, EpiRelu2{ss_h1, (bf16_t*)(ws + OFF_HID0)}); }
    xcd_barrier(xb, phase_tid(wave_id));
    PH(5) { WSDEF gemm_phase(wave_id, lds, Gemm{(const bf16_t*)(ws + OFF_HID0), (const bf16_t*)(ws + OFF_WDN0), T_, 1024, 4096, 4096, 256, 1}, EpiRes<false>{XB0, (bf16_t*)p.out, ss_h2}); }
    xcd_barrier(xb, phase_tid(wave_id));
    PH(6) { WSDEF gemm_phase(wave_id, lds, Gemm{(const bf16_t*)p.out, (const bf16_t*)(ws + OFF_WDKVQ), T_, 768, 1024, 1024, 256, 0},
               EpiDKVQ{ss_h2, (bf16_t*)(ws + OFF_CKV), (bf16_t*)(ws + OFF_CQ), (bf16_t*)(ws + OFF_KR), ss_ckv, ss_cq, rope}); }
    xcd_barrier(xb, phase_tid(wave_id));
    PH(7) { WSDEF gemm_phase(wave_id, lds, Gemm{(const bf16_t*)(ws + OFF_CKV), (const bf16_t*)(ws + OFF_WUKV), T_, 2048, 256, 256, 256, 0}, EpiKN{ss_ckv, (bf16_t*)(ws + OFF_KN)}); }
    PH(8) { WSDEF gemm_phase(wave_id, lds, Gemm{(const bf16_t*)(ws + OFF_WUKV) + (size_t)2048 * 256, (const bf16_t*)(ws + OFF_CKV), 2048, T_, 256, 256, 256, 0}, EpiVT{ss_ckv, (bf16_t*)(ws + OFF_VT)}); }
    PH(9) { WSDEF gemm_phase(wave_id, lds, Gemm{(const bf16_t*)(ws + OFF_CQ), (const bf16_t*)(ws + OFF_WUQ), T_, 3072, 256, 256, 256, 0}, EpiQ{ss_cq, (bf16_t*)(ws + OFF_Q), rope}); }
    xcd_barrier(xb, phase_tid(wave_id));
    PH(10) attn_phase(wave_id, p, lds);
    xcd_barrier(xb, phase_tid(wave_id));
    PH(11) { WSDEF gemm_phase(wave_id, lds, Gemm{(const bf16_t*)(ws + OFF_Q), (const bf16_t*)(ws + OFF_WMWO), T_, 1024, 2048, 3072, 384, 0}, EpiRes<false>{(const bf16_t*)p.out, (bf16_t*)(ws + OFF_XB3), ss_h3}); }
    xcd_barrier(xb, phase_tid(wave_id));
    PH(12) { WSDEF gemm_phase(wave_id, lds, Gemm{(const bf16_t*)(ws + OFF_XB3), (const bf16_t*)(ws + OFF_WUP1), T_, 4096, 1024, 1024, 256, 0}, EpiRelu2{ss_h3, (bf16_t*)(ws + OFF_HID1)}); }
    xcd_barrier(xb, phase_tid(wave_id));
    PH(13) { WSDEF gemm_phase(wave_id, lds, Gemm{(const bf16_t*)(ws + OFF_HID1), (const bf16_t*)(ws + OFF_WDN1), T_, 1024, 4096, 4096, 256, 1}, EpiRes<false>{(const bf16_t*)(ws + OFF_XB3), (bf16_t*)(ws + OFF_XB3), ss_h4}); }
    xcd_barrier(xb, phase_tid(wave_id));
    PH(14) final_phase(wave_id, p);
}

extern "C" void kernel_launch(void* const* d_in, const int* in_sizes, int n_in, void* d_out, int out_size, void* d_ws, size_t ws_size, hipStream_t stream) {
    static int grid_blocks = 0;
    if (!grid_blocks) {
        int dev = 0, cus = 0, per_cu = 0;
        hipGetDevice(&dev);
        hipDeviceGetAttribute(&cus, hipDeviceAttributeMultiprocessorCount, dev);
        if (hipFuncSetAttribute((const void*)fwd_megakernel, hipFuncAttributeMaxDynamicSharedMemorySize, LDS_BYTES) != hipSuccess) fprintf(stderr, "hipFuncSetAttribute failed\n");
        hipOccupancyMaxActiveBlocksPerMultiprocessor(&per_cu, (const void*)fwd_megakernel, 512, LDS_BYTES);
        if (per_cu < 1) per_cu = 1;
        grid_blocks = cus * per_cu;
        if (grid_blocks > 256) grid_blocks = 256;
        if (ws_size < WS_NEED) fprintf(stderr, "workspace too small: %zu < %zu\n", ws_size, (size_t)WS_NEED);
    }
    Params p{};
    const float** pp = (const float**)&p;
    for (int i = 0; i < 23; ++i) pp[i] = (const float*)d_in[i];
    p.out = (float*)d_out;
    p.ws = (unsigned char*)d_ws;
    hipMemsetAsync((unsigned char*)d_ws + OFF_BAR, 0, XCD_BAR_WORDS * 4, stream);
    void* args[] = {&p};
    hipError_t e = hipLaunchCooperativeKernel((const void*)fwd_megakernel, dim3(grid_blocks), dim3(512), args, LDS_BYTES, stream);
    if (e != hipSuccess) fprintf(stderr, "cooperative launch failed: %s (grid %d)\n", hipGetErrorString(e), grid_blocks);
}
```

```cpp
#include <hip/hip_runtime.h>
#include <hip/hip_cooperative_groups.h>
#include <cstdio>
#include <cstdint>
namespace cg = cooperative_groups;

#define LAS __attribute__((address_space(3)))
#define DI __device__ __forceinline__
typedef unsigned short bf16_t;
typedef short bf16x8 __attribute__((ext_vector_type(8)));
typedef float f32x4 __attribute__((ext_vector_type(4)));
typedef float f32x16 __attribute__((ext_vector_type(16)));
typedef unsigned u32x4 __attribute__((ext_vector_type(4)));
typedef unsigned u32x2 __attribute__((ext_vector_type(2)));
typedef __bf16 bf2_t __attribute__((ext_vector_type(2)));
typedef float f2_t __attribute__((ext_vector_type(2)));
typedef _Float16 h2_t __attribute__((ext_vector_type(2)));

constexpr int T_ = 32768;
constexpr int SEQ_ = 4096;
constexpr float EPS_ = 1e-6f;
constexpr size_t MiB = 1ull << 20;
constexpr size_t OFF_A = 0, OFF_B = 256 * MiB, OFF_C = 448 * MiB;
constexpr size_t OFF_HQ = OFF_A;
constexpr size_t OFF_HID0 = OFF_A;
constexpr size_t OFF_KN = OFF_A, OFF_VT = OFF_A + 128 * MiB;
constexpr size_t OFF_XB3 = OFF_A;
constexpr size_t OFF_HID1 = OFF_A + 64 * MiB;
constexpr size_t OFF_XB0 = OFF_B;
constexpr size_t OFF_OG = OFF_B + 64 * MiB;
constexpr size_t OFF_WHG = OFF_B + 128 * MiB;
constexpr size_t OFF_WWO = OFF_WHG + 8 * MiB;
constexpr size_t OFF_WUP0 = OFF_WWO + 2 * MiB;
constexpr size_t OFF_WDN0 = OFF_WUP0 + 8 * MiB;
constexpr size_t OFF_WDKVQ = OFF_WDN0 + 8 * MiB;
constexpr size_t OFF_Q = OFF_B;
constexpr size_t OFF_CKV = OFF_C, OFF_CQ = OFF_C + 16 * MiB, OFF_KR = OFF_C + 32 * MiB;
constexpr size_t OFF_WUKV = OFF_C + 36 * MiB;
constexpr size_t OFF_WUQ = OFF_WUKV + 2 * MiB;
constexpr size_t OFF_WMWO = OFF_WUQ + 3 * MiB / 2;
constexpr size_t OFF_WUP1 = OFF_WMWO + 4 * MiB;
constexpr size_t OFF_WDN1 = OFF_WUP1 + 8 * MiB;
constexpr size_t OFF_ROPE = OFF_WDN1 + 8 * MiB;
constexpr size_t OFF_SS = OFF_ROPE + 1 * MiB;
constexpr size_t OFF_LB = OFF_SS + 7 * (size_t)T_ * 4;
constexpr size_t WS_NEED = OFF_LB + 65536 + 16384;
constexpr size_t OFF_BAR = OFF_LB + 65536;
constexpr int LDS_BYTES = 131072 + 16;

struct Params {
    const float *x, *hgrn_norm, *w_q, *w_f, *w_i, *w_g, *g_norm, *w_o, *lb_logits, *mla_norm, *w_dq, *q_norm, *w_uq, *mla_w_o,
        *kv_in_norm, *w_dkv, *kv_norm, *w_uk, *w_uv, *mlp_norm, *w_up, *w_down, *final_norm;
    float* out;
    unsigned char* ws;
};

DI int phase_tid(int w) {
    asm volatile("" : "+s"(w));
    int l;
    asm volatile("v_mbcnt_lo_u32_b32 %0, -1, 0\n\tv_mbcnt_hi_u32_b32 %0, -1, %0" : "=v"(l));
    return w * 64 + l;
}
DI unsigned pk_bf16(float a, float b) { f2_t f = {a, b}; bf2_t h = __builtin_convertvector(f, bf2_t); return __builtin_bit_cast(unsigned, h); }
DI unsigned pk_f16(float a, float b) { f2_t f = {a, b}; h2_t h = __builtin_convertvector(f, h2_t); return __builtin_bit_cast(unsigned, h); }
DI bf16_t bf16_1(float a) { return (bf16_t)(pk_bf16(a, 0.f) & 0xffffu); }
DI float bf2f(unsigned short b) { return __uint_as_float((unsigned)b << 16); }
DI float fast_exp(float x) { return __builtin_amdgcn_exp2f(x * 1.4426950408889634f); }
DI float fast_rcp(float x) { return __builtin_amdgcn_rcpf(x); }
DI float sigmoidf_(float x) { return fast_rcp(1.0f + fast_exp(-x)); }

#define XB_TMO      128
#define XB_XCNT(j)  (256  + 64 * (j))
#define XB_XSUB(j)  (1280 + 64 * (j))
#define XB_XGEN(j)  (2304 + 64 * (j))
#define XB_TOP      3328
#define XB_TOPGEN   3392
#define XCD_BAR_WORDS 3456
#define XB_SPIN_CAP (1u << 18)

__device__ __forceinline__ unsigned xb_ld(unsigned* p)              { return __hip_atomic_load(p, __ATOMIC_RELAXED, __HIP_MEMORY_SCOPE_AGENT); }
__device__ __forceinline__ unsigned xb_add(unsigned* p, unsigned v) { return __hip_atomic_fetch_add(p, v, __ATOMIC_RELAXED, __HIP_MEMORY_SCOPE_AGENT); }
__device__ __forceinline__ unsigned xb_xcc_id() { return (unsigned)__builtin_amdgcn_s_getreg((3 << 11) | 20) & 0xFu; }
#define XB_SPIN(cond, bar) do { unsigned _sp = 0; while (cond) { __builtin_amdgcn_s_sleep(1); \
    if ((++_sp & 255u) == 0u) { if (xb_ld(&(bar)[XB_TMO])) break; if (_sp > XB_SPIN_CAP) { atomicAdd(&(bar)[XB_TMO], 1u); break; } } } } while (0)

struct XcdBarrier {
    unsigned* bar; unsigned x;
    volatile LAS unsigned* st;
};

__device__ __forceinline__ XcdBarrier xcd_barrier_post(unsigned* bar, volatile LAS unsigned* st, int tid) {
    XcdBarrier b; b.bar = bar; b.x = xb_xcc_id(); b.st = st;
    if (tid == 0) (void)xb_add(&bar[XB_XCNT(b.x)], 1u);
    return b;
}
__device__ __forceinline__ void xcd_barrier_complete(unsigned* bar, unsigned x, unsigned& nloc, unsigned& nx) {
    const unsigned G = gridDim.x * gridDim.y * gridDim.z;
    unsigned sum, cnt, mine, sp = 0u;
    for (;;) {
        sum = 0u; cnt = 0u; mine = 0u;
#pragma unroll
        for (unsigned j = 0; j < 16; ++j) { const unsigned c = xb_ld(&bar[XB_XCNT(j)]); sum += c; cnt += (c > 0u) ? 1u : 0u; mine = (j == x) ? c : mine; }
        if (sum == G) break;
        __builtin_amdgcn_s_sleep(1);
        if ((++sp & 255u) == 0u) { if (xb_ld(&bar[XB_TMO])) break; if (sp > XB_SPIN_CAP) { atomicAdd(&bar[XB_TMO], 1u); break; } }
    }
    nloc = mine > 0u ? mine : 1u; nx = cnt > 0u ? cnt : 1u;
}

__device__ __forceinline__ void xcd_barrier(const XcdBarrier& b, int tid) {
    asm volatile("s_waitcnt vmcnt(0)" ::: "memory");
    __syncthreads();
    if (tid == 0) {
        unsigned* bar = b.bar;
        __builtin_amdgcn_s_waitcnt(0);
        unsigned nloc = b.st[0], nx = b.st[1];
        if (nloc == 0u) { xcd_barrier_complete(bar, b.x, nloc, nx); b.st[0] = nloc; b.st[1] = nx; }
        const unsigned old = xb_add(&bar[XB_XSUB(b.x)], 1u);
        const unsigned gen = old / nloc;
        if (old + 1u == (gen + 1u) * nloc) {
            __builtin_amdgcn_fence(__ATOMIC_RELEASE, "agent");
            asm volatile("s_waitcnt vmcnt(0)" ::: "memory");
            const unsigned og = xb_add(&bar[XB_TOP], 1u);
            const unsigned tg = og / nx;
            if (og + 1u == (tg + 1u) * nx) xb_add(&bar[XB_TOPGEN], 1u);
            else XB_SPIN(xb_ld(&bar[XB_TOPGEN]) == tg, bar);
            __builtin_amdgcn_fence(__ATOMIC_ACQUIRE, "agent");
            xb_add(&bar[XB_XGEN(b.x)], 1u);
            asm volatile("s_waitcnt vmcnt(0)" ::: "memory");
        } else {
            XB_SPIN(xb_ld(&bar[XB_XGEN(b.x)]) == gen, bar);
            __builtin_amdgcn_fence(__ATOMIC_ACQUIRE, "agent");
            asm volatile("s_waitcnt vmcnt(0)" ::: "memory");
        }
    }
    __syncthreads();
}

namespace pg8 {
constexpr int BM = 256, BK = 64, HALF = 128, HTB = HALF * BK * 2, NXCD = 8, WGM = 8;
DI int lds_byte(int r, int c) { const int st = (r >> 4) * 2 + (c >> 5), rr = r & 15, cc = c & 31, ob = rr * 64 + cc * 2; return st * 1024 + (ob ^ (((ob >> 9) & 1) << 5)); }
DI void stage_rc(int b, int& R, int& C) { const int st = b / 1024, sb = b % 1024, swz = sb ^ (((sb >> 9) & 1) << 5); R = (st >> 1) * 16 + swz / 64; C = (st & 1) * 32 + (swz % 64) / 2; }
DI int perm32(int rho) { const int n = rho >> 4, i = rho & 15; return 8 * (i >> 2) + 4 * n + (i & 3); }
struct Unit { int pm, pn; };
struct Gemm { const bf16_t* A; const bf16_t* Bt; int M, N, K, lda, a2step, rev; };
struct StaticOrder {
    int nM, nN, nwg, G, c;
    int rev;
    DI void init(int M, int N, int G_, int c_, int rev_) { nM = M / BM; nN = N / BM; nwg = nM * nN; G = G_; c = c_; rev = rev_; }
    DI bool next(int i, Unit& u) const {
        const long L = (long)i * G + c; if (L >= nwg) return false;
        int wgid = (int)L; { const int q = nwg / NXCD, r = nwg % NXCD, xcd = wgid % NXCD, off = wgid / NXCD; wgid = (xcd < r ? xcd * (q + 1) : r * (q + 1) + (xcd - r) * q) + off; }
        const int nig = WGM * nN, gid = wgid / nig, fm = gid * WGM, gsz = (nM - fm) < WGM ? (nM - fm) : WGM;
        u.pm = fm + ((wgid % nig) % gsz); u.pn = (wgid % nig) / gsz; if (rev) u.pm = nM - 1 - u.pm; return true;
    }
};

template <class Epi>
DI void gemm_phase(int wave_id, LAS unsigned char* lds, const Gemm g, const Epi& E) {
    StaticOrder S; S.init(g.M, g.N, gridDim.x, blockIdx.x, g.rev);
    const int tid = phase_tid(wave_id),
              wid = __builtin_amdgcn_readfirstlane(tid >> 6), lane = tid & 63, wr = wid >> 2, wc = wid & 3, fr = lane & 15, fq = lane >> 4;
    const int K = g.K, nt = K / BK;
    unsigned voffA[2], voffB[2];
#pragma unroll
    for (int i = 0; i < 2; ++i) { int R, C; stage_rc(tid * 16 + i * 8192, R, C); const int Rb = (R & ~31) + perm32(R & 31); voffA[i] = (unsigned)(R * g.lda + C) * 2u; voffB[i] = (unsigned)(Rb * K + C) * 2u; }
    const size_t kstep = (size_t)(BK * 2);
    const size_t hstepA = (size_t)HALF * g.lda * 2, tstepA = 2 * hstepA;
    const size_t hstepB = (size_t)HALF * K * 2, tstepB = 2 * hstepB;
    const size_t a2 = (size_t)g.a2step;
    const unsigned ldsw = (unsigned)wid * 1024u;
    const int aoff = lds_byte(wr * 64 + fr, fq * 8), boff = lds_byte(wc * 32 + fr, fq * 8);
#define PG8_SA(b, h) (((b) * 2 + (h)) * HTB)
#define PG8_SB(b, h) ((4 + (b) * 2 + (h)) * HTB)
#define PG8_STAGE(bufoff, gbase, voff) do { _Pragma("unroll") for (int _i = 0; _i < 2; ++_i) \
        __builtin_amdgcn_global_load_lds((const unsigned*)((const char*)(gbase) + (voff)[_i]), (LAS unsigned*)(lds + (bufoff) + ldsw + _i * 8192), 16, 0, 0); } while (0)
#define PG8_LDA(dst, b, h) do { _Pragma("unroll") for (int m = 0; m < 4; ++m) _Pragma("unroll") for (int k = 0; k < 2; ++k) dst[m][k] = *(const LAS bf16x8*)(lds + PG8_SA(b, h) + aoff + m * 2048 + k * 1024); } while (0)
#define PG8_LDB(dst, b, h) do { _Pragma("unroll") for (int n = 0; n < 2; ++n) _Pragma("unroll") for (int k = 0; k < 2; ++k) dst[n][k] = *(const LAS bf16x8*)(lds + PG8_SB(b, h) + boff + n * 2048 + k * 1024); } while (0)
#define PG8_MMA(ai, bj, At, Bt) do { __builtin_amdgcn_s_setprio(1); _Pragma("unroll") for (int m = 0; m < 4; ++m) _Pragma("unroll") for (int n = 0; n < 2; ++n) _Pragma("unroll") for (int k = 0; k < 2; ++k) \
        acc[ai][bj][m][n] = __builtin_amdgcn_mfma_f32_16x16x32_bf16(Bt[n][k], At[m][k], acc[ai][bj][m][n], 0, 0, 0); __builtin_amdgcn_s_setprio(0); } while (0)
#define PG8_WAIT_V(n) asm volatile("s_waitcnt vmcnt(" #n ")" ::: "memory")
#define PG8_WAIT_L(n) asm volatile("s_waitcnt lgkmcnt(" #n ")" ::: "memory")
#define PG8_BAR __builtin_amdgcn_s_barrier()
#define PG8_SCHED __builtin_amdgcn_sched_barrier(0)
    Unit cur, nxt; int ui = 0;
    if (!S.next(0, cur)) return;
    f32x4 acc[2][2][4][2];
#pragma unroll
    for (int a = 0; a < 2; ++a)
#pragma unroll
        for (int b = 0; b < 2; ++b)
#pragma unroll
            for (int m = 0; m < 4; ++m)
#pragma unroll
                for (int n = 0; n < 2; ++n) acc[a][b][m][n] = (f32x4){0.f, 0.f, 0.f, 0.f};
    bf16x8 At[4][2], B0[2][2], B1[2][2];
    const char* cA = (const char*)g.A + (size_t)cur.pm * tstepA; const char* cB = (const char*)g.Bt + (size_t)cur.pn * tstepB;
    constexpr bool SP2 = true, ALIGN_EPI = true;
    if constexpr (SP2) {
        PG8_STAGE(PG8_SB(0, 0), cB, voffB); PG8_STAGE(PG8_SB(0, 1), cB + hstepB, voffB); PG8_STAGE(PG8_SA(0, 0), cA, voffA); PG8_STAGE(PG8_SA(0, 1), cA + hstepA, voffA);
        if (wr == 1) PG8_BAR;
        PG8_WAIT_V(2); PG8_BAR;
        PG8_STAGE(PG8_SB(1, 0), cB + kstep, voffB); PG8_STAGE(PG8_SA(1, 0), cA + kstep, voffA); PG8_STAGE(PG8_SB(1, 1), cB + hstepB + kstep, voffB);
        PG8_WAIT_V(6); PG8_BAR;
    } else {
    PG8_STAGE(PG8_SB(0, 0), cB, voffB); PG8_STAGE(PG8_SA(0, 0), cA, voffA); PG8_STAGE(PG8_SB(0, 1), cB + hstepB, voffB); PG8_STAGE(PG8_SA(0, 1), cA + hstepA, voffA);
    if (wr == 1) PG8_BAR;
    PG8_WAIT_V(4); PG8_BAR;
    PG8_STAGE(PG8_SB(1, 0), cB + kstep, voffB); PG8_STAGE(PG8_SA(1, 0), cA + kstep, voffA); PG8_STAGE(PG8_SB(1, 1), cB + hstepB + kstep, voffB);
    PG8_WAIT_V(6); PG8_BAR;
    }
    for (;;) {
        const bool has_next = S.next(ui + 1, nxt);
        const char* nA = has_next ? (const char*)g.A + (size_t)nxt.pm * tstepA : cA; const char* nB = has_next ? (const char*)g.Bt + (size_t)nxt.pn * tstepB : cB;
        for (int t = 0; t < nt; t += 2) {
            const bool last = (t == nt - 2);
            const char* a1 = cA + (size_t)(t >> 1) * a2 + kstep;
            const char* a2p = last ? nA : cA + (size_t)((t >> 1) + 1) * a2; const char* b2 = last ? nB : cB + (size_t)(t + 2) * kstep;
            const char* a3 = a2p + kstep; const char* b3 = b2 + kstep;
            if constexpr (SP2) {
            PG8_LDB(B0, 0, 0); PG8_LDB(B1, 0, 1); PG8_SCHED; PG8_LDA(At, 0, 0); PG8_STAGE(PG8_SA(1, 1), a1 + hstepA, voffA);
            PG8_WAIT_V(8); PG8_WAIT_L(0); PG8_BAR; PG8_MMA(0, 0, At, B0); PG8_MMA(0, 1, At, B1); PG8_BAR; PG8_SCHED;
            PG8_LDA(At, 0, 1); PG8_STAGE(PG8_SB(0, 0), b2, voffB); PG8_STAGE(PG8_SB(0, 1), b2 + hstepB, voffB); PG8_STAGE(PG8_SA(0, 0), a2p, voffA);
            PG8_WAIT_V(8); PG8_WAIT_L(0); PG8_BAR; PG8_MMA(1, 0, At, B0); PG8_MMA(1, 1, At, B1); PG8_BAR; PG8_SCHED;
            PG8_LDB(B0, 1, 0); PG8_LDB(B1, 1, 1); PG8_SCHED; PG8_LDA(At, 1, 0); PG8_STAGE(PG8_SA(0, 1), a2p + hstepA, voffA);
            PG8_WAIT_V(8); PG8_WAIT_L(0); PG8_BAR; PG8_MMA(0, 0, At, B0); PG8_MMA(0, 1, At, B1); PG8_BAR; PG8_SCHED;
            PG8_LDA(At, 1, 1); PG8_STAGE(PG8_SB(1, 0), b3, voffB); PG8_STAGE(PG8_SB(1, 1), b3 + hstepB, voffB); PG8_STAGE(PG8_SA(1, 0), a3, voffA);
            PG8_WAIT_V(8); PG8_WAIT_L(0); PG8_BAR; PG8_MMA(1, 0, At, B0); PG8_MMA(1, 1, At, B1); PG8_BAR; PG8_SCHED;
            } else {
            PG8_LDB(B0, 0, 0); PG8_SCHED; PG8_LDA(At, 0, 0); PG8_STAGE(PG8_SA(1, 1), a1 + hstepA, voffA);
            PG8_WAIT_L(8); PG8_BAR; PG8_WAIT_L(0); PG8_MMA(0, 0, At, B0); PG8_BAR; PG8_SCHED;
            PG8_LDB(B1, 0, 1); PG8_STAGE(PG8_SB(0, 0), b2, voffB);
            PG8_BAR; PG8_WAIT_L(0); PG8_MMA(0, 1, At, B1); PG8_BAR;
            PG8_LDA(At, 0, 1); PG8_STAGE(PG8_SA(0, 0), a2p, voffA);
            PG8_BAR; PG8_WAIT_L(0); PG8_MMA(1, 0, At, B0); PG8_BAR; PG8_SCHED;
            PG8_STAGE(PG8_SB(0, 1), b2 + hstepB, voffB);
            PG8_WAIT_V(6); PG8_BAR; PG8_MMA(1, 1, At, B1); PG8_BAR;
            PG8_LDB(B0, 1, 0); PG8_SCHED; PG8_LDA(At, 1, 0); PG8_STAGE(PG8_SA(0, 1), a2p + hstepA, voffA);
            PG8_WAIT_L(8); PG8_BAR; PG8_WAIT_L(0); PG8_MMA(0, 0, At, B0); PG8_BAR; PG8_SCHED;
            PG8_LDB(B1, 1, 1); PG8_STAGE(PG8_SB(1, 0), b3, voffB);
            PG8_BAR; PG8_WAIT_L(0); PG8_MMA(0, 1, At, B1); PG8_BAR;
            PG8_LDA(At, 1, 1); PG8_STAGE(PG8_SA(1, 0), a3, voffA);
            PG8_BAR; PG8_WAIT_L(0); PG8_MMA(1, 0, At, B0); PG8_BAR; PG8_SCHED;
            PG8_STAGE(PG8_SB(1, 1), b3 + hstepB, voffB);
            PG8_WAIT_V(6); PG8_BAR; PG8_MMA(1, 1, At, B1); PG8_BAR;
            }
        }
        if constexpr (ALIGN_EPI) { if (wr == 0) PG8_BAR; }
        E(acc, cur, wr, wc, fr, fq);
        if (!has_next) break;
#pragma unroll
        for (int a = 0; a < 2; ++a)
#pragma unroll
            for (int b = 0; b < 2; ++b)
#pragma unroll
                for (int m = 0; m < 4; ++m)
#pragma unroll
                    for (int n = 0; n < 2; ++n) acc[a][b][m][n] = (f32x4){0.f, 0.f, 0.f, 0.f};
        cur = nxt; cA = nA; cB = nB; ++ui;
        if constexpr (ALIGN_EPI) { if (wr == 1) PG8_BAR; }
    }
    PG8_WAIT_V(0);
    if constexpr (!ALIGN_EPI) { if (wr == 0) PG8_BAR; }
    PG8_BAR;
#undef PG8_SA
#undef PG8_SB
#undef PG8_STAGE
#undef PG8_LDA
#undef PG8_LDB
#undef PG8_MMA
}

typedef const f32x4 (&AccRef)[2][2][4][2];
DI u32x4 pk8(const f32x4 a, const f32x4 b) { return (u32x4){pk_bf16(a[0], a[1]), pk_bf16(a[2], a[3]), pk_bf16(b[0], b[1]), pk_bf16(b[2], b[3])}; }
DI void rope4(f32x4& a, f32x4& b, const f2_t* rp) {
    const f32x4 c01 = *(const f32x4*)rp, c23 = *(const f32x4*)(rp + 2);
    const f32x4 oa = {a[0] * c01[0] - a[1] * c01[1], a[1] * c01[0] + a[0] * c01[1], a[2] * c01[2] - a[3] * c01[3], a[3] * c01[2] + a[2] * c01[3]};
    const f32x4 ob = {b[0] * c23[0] - b[1] * c23[1], b[1] * c23[0] + b[0] * c23[1], b[2] * c23[2] - b[3] * c23[3], b[3] * c23[2] + b[2] * c23[3]};
    a = oa; b = ob;
}

struct EpiHG {
    const float* ss; const float* lb; bf16_t* out;
    DI void operator()(AccRef acc, const Unit& u, int wr, int wc, int fr, int fq) const {
        const int type = u.pn >> 2;
        const int cbase = (u.pn & 3) * 256 + wc * 32 + 8 * fq;
        bf16_t* o = out + (size_t)(type == 2 ? 3 : type) * T_ * 1024;
#pragma unroll
        for (int ai = 0; ai < 2; ++ai)
#pragma unroll
            for (int m = 0; m < 4; ++m) {
                const int row = u.pm * 256 + ai * 128 + wr * 64 + m * 16 + fr;
                const float rs = rsqrtf(ss[row] * (1.0f / 1024.0f) + EPS_);
#pragma unroll
                for (int bj = 0; bj < 2; ++bj) {
                    const int col = cbase + bj * 128;
                    f32x4 v0 = acc[ai][bj][m][0] * rs, v1 = acc[ai][bj][m][1] * rs;
                    u32x4 w;
                    if (type != 1) {
#pragma unroll
                        for (int j = 0; j < 4; ++j) { v0[j] = v0[j] * sigmoidf_(v0[j]); v1[j] = v1[j] * sigmoidf_(v1[j]); }
                        w = pk8(v0, v1);
                    } else {
                        const f32x4 l0 = *(const f32x4*)(lb + col), l1 = *(const f32x4*)(lb + col + 4);
#pragma unroll
                        for (int j = 0; j < 4; ++j) { v0[j] = __logf(l0[j] + (1.0f - l0[j]) * sigmoidf_(v0[j])); v1[j] = __logf(l1[j] + (1.0f - l1[j]) * sigmoidf_(v1[j])); }
                        w = (u32x4){pk_f16(v0[0], v0[1]), pk_f16(v0[2], v0[3]), pk_f16(v1[0], v1[1]), pk_f16(v1[2], v1[3])};
                    }
                    *(u32x4*)(o + (size_t)row * 1024 + col) = w;
                }
            }
    }
};

struct EpiHVT {
    const float* ss; bf16_t* out;
    DI void operator()(AccRef acc, const Unit& u, int wr, int wc, int fr, int fq) const {
        const int cbase = u.pn * 256 + wc * 32 + 8 * fq;
#pragma unroll
        for (int bj = 0; bj < 2; ++bj) {
            const int tok = cbase + bj * 128;
            const f32x4 sa = *(const f32x4*)(ss + tok), sb = *(const f32x4*)(ss + tok + 4);
            f32x4 r0, r1;
#pragma unroll
            for (int j = 0; j < 4; ++j) { r0[j] = rsqrtf(sa[j] * (1.0f / 1024.0f) + EPS_); r1[j] = rsqrtf(sb[j] * (1.0f / 1024.0f) + EPS_); }
            const int bc = tok >> 6, s = tok & 63;
#pragma unroll
            for (int ai = 0; ai < 2; ++ai)
#pragma unroll
                for (int m = 0; m < 4; ++m) {
                    const int hv = u.pm * 256 + ai * 128 + wr * 64 + m * 16 + fr;
                    *(u32x4*)(out + ((size_t)(bc * 8 + (hv >> 7)) * 128 + (hv & 127)) * 64 + s) = pk8(acc[ai][bj][m][0] * r0, acc[ai][bj][m][1] * r1);
                }
        }
    }
};

template <bool RES_F32>
struct EpiRes {
    const void* res; bf16_t* xb; float* ss;
    DI void operator()(AccRef acc, const Unit& u, int wr, int wc, int fr, int fq) const {
        const int cbase = u.pn * 256 + wc * 32 + 8 * fq;
#pragma unroll
        for (int ai = 0; ai < 2; ++ai)
#pragma unroll
            for (int m = 0; m < 4; ++m) {
                const int row = u.pm * 256 + ai * 128 + wr * 64 + m * 16 + fr;
                float sq = 0.f;
#pragma unroll
                for (int bj = 0; bj < 2; ++bj) {
                    const size_t off = (size_t)row * 1024 + cbase + bj * 128;
                    f32x4 r0, r1;
                    if (RES_F32) { r0 = *(const f32x4*)((const float*)res + off); r1 = *(const f32x4*)((const float*)res + off + 4); }
                    else { const u32x4 rb = *(const u32x4*)((const bf16_t*)res + off);
                        r0 = (f32x4){__uint_as_float(rb.x << 16), __uint_as_float(rb.x & 0xffff0000u), __uint_as_float(rb.y << 16), __uint_as_float(rb.y & 0xffff0000u)};
                        r1 = (f32x4){__uint_as_float(rb.z << 16), __uint_as_float(rb.z & 0xffff0000u), __uint_as_float(rb.w << 16), __uint_as_float(rb.w & 0xffff0000u)}; }
                    const f32x4 v0 = acc[ai][bj][m][0] + r0, v1 = acc[ai][bj][m][1] + r1;
                    *(u32x4*)(xb + off) = pk8(v0, v1);
                    sq += ((v0[0] * v0[0] + v0[1] * v0[1]) + (v0[2] * v0[2] + v0[3] * v0[3])) + ((v1[0] * v1[0] + v1[1] * v1[1]) + (v1[2] * v1[2] + v1[3] * v1[3]));
                }
                sq += __shfl_xor(sq, 16); sq += __shfl_xor(sq, 32);
                if (fq == 0) unsafeAtomicAdd(ss + row, sq);
            }
    }
};

struct EpiRelu2 {
    const float* ss; bf16_t* out;
    DI void operator()(AccRef acc, const Unit& u, int wr, int wc, int fr, int fq) const {
        const int cbase = u.pn * 256 + wc * 32 + 8 * fq;
#pragma unroll
        for (int ai = 0; ai < 2; ++ai)
#pragma unroll
            for (int m = 0; m < 4; ++m) {
                const int row = u.pm * 256 + ai * 128 + wr * 64 + m * 16 + fr;
                const float rs = rsqrtf(ss[row] * (1.0f / 1024.0f) + EPS_);
#pragma unroll
                for (int bj = 0; bj < 2; ++bj) {
                    f32x4 v0 = acc[ai][bj][m][0] * rs, v1 = acc[ai][bj][m][1] * rs;
#pragma unroll
                    for (int j = 0; j < 4; ++j) { const float t0 = fmaxf(v0[j], 0.f), t1 = fmaxf(v1[j], 0.f); v0[j] = t0 * t0; v1[j] = t1 * t1; }
                    *(u32x4*)(out + (size_t)row * 4096 + cbase + bj * 128) = pk8(v0, v1);
                }
            }
    }
};

struct EpiDKVQ {
    const float* ss; bf16_t* ckv; bf16_t* cq; bf16_t* kr; float* ss_ckv; float* ss_cq; const f2_t* rope;
    DI void operator()(AccRef acc, const Unit& u, int wr, int wc, int fr, int fq) const {
#pragma unroll
        for (int ai = 0; ai < 2; ++ai)
#pragma unroll
            for (int m = 0; m < 4; ++m) {
                const int row = u.pm * 256 + ai * 128 + wr * 64 + m * 16 + fr;
                const float rs = rsqrtf(ss[row] * (1.0f / 1024.0f) + EPS_);
                if (u.pn < 2) {
                    bf16_t* dst = u.pn ? cq : ckv; float* sd = u.pn ? ss_cq : ss_ckv;
                    float sq = 0.f;
#pragma unroll
                    for (int bj = 0; bj < 2; ++bj) {
                        const int col = bj * 128 + wc * 32 + 8 * fq;
                        const f32x4 v0 = acc[ai][bj][m][0] * rs, v1 = acc[ai][bj][m][1] * rs;
                        *(u32x4*)(dst + (size_t)row * 256 + col) = pk8(v0, v1);
                        sq += ((v0[0] * v0[0] + v0[1] * v0[1]) + (v0[2] * v0[2] + v0[3] * v0[3])) + ((v1[0] * v1[0] + v1[1] * v1[1]) + (v1[2] * v1[2] + v1[3] * v1[3]));
                    }
                    sq += __shfl_xor(sq, 16); sq += __shfl_xor(sq, 32);
                    if (fq == 0) unsafeAtomicAdd(sd + row, sq);
                } else if (wc < 2) {
                    const int pos = row & (SEQ_ - 1);
                    const int col = wc * 32 + 8 * fq;
                    f32x4 v0 = acc[ai][0][m][0] * rs, v1 = acc[ai][0][m][1] * rs;
                    rope4(v0, v1, rope + pos * 32 + (col >> 1));
                    *(u32x4*)(kr + (size_t)row * 64 + col) = pk8(v0, v1);
                }
            }
    }
};

struct EpiKN {
    const float* ss; bf16_t* out;
    DI void operator()(AccRef acc, const Unit& u, int wr, int wc, int fr, int fq) const {
        const int cbase = u.pn * 256 + wc * 32 + 8 * fq;
#pragma unroll
        for (int ai = 0; ai < 2; ++ai)
#pragma unroll
            for (int m = 0; m < 4; ++m) {
                const int row = u.pm * 256 + ai * 128 + wr * 64 + m * 16 + fr;
                const float rs = rsqrtf(ss[row] * (1.0f / 256.0f) + EPS_);
#pragma unroll
                for (int bj = 0; bj < 2; ++bj)
                    *(u32x4*)(out + (size_t)row * 2048 + cbase + bj * 128) = pk8(acc[ai][bj][m][0] * rs, acc[ai][bj][m][1] * rs);
            }
    }
};

struct EpiVT {
    const float* ss; bf16_t* out;
    DI void operator()(AccRef acc, const Unit& u, int wr, int wc, int fr, int fq) const {
        const int cbase = u.pn * 256 + wc * 32 + 8 * fq;
#pragma unroll
        for (int bj = 0; bj < 2; ++bj)
#pragma unroll
            for (int n = 0; n < 2; ++n) {
                const int tok = cbase + bj * 128 + 4 * n;
                const f32x4 s4 = *(const f32x4*)(ss + tok);
                f32x4 rs;
#pragma unroll
                for (int j = 0; j < 4; ++j) rs[j] = rsqrtf(s4[j] * (1.0f / 256.0f) + EPS_);
                const int b = tok >> 12, s = tok & (SEQ_ - 1);
                const int ps = (s & ~12) | ((s & 4) << 1) | ((s & 8) >> 1);
#pragma unroll
                for (int ai = 0; ai < 2; ++ai)
#pragma unroll
                    for (int m = 0; m < 4; ++m) {
                        const int hv = u.pm * 256 + ai * 128 + wr * 64 + m * 16 + fr;
                        const f32x4 v = acc[ai][bj][m][n] * rs;
                        u32x2 w; w.x = pk_bf16(v[0], v[1]); w.y = pk_bf16(v[2], v[3]);
                        *(u32x2*)(out + ((size_t)(b * 2048 + hv) * SEQ_ + ps)) = w;
                    }
            }
    }
};

struct EpiQ {
    const float* ss; bf16_t* out; const f2_t* rope;
    DI void operator()(AccRef acc, const Unit& u, int wr, int wc, int fr, int fq) const {
        const int cbase = u.pn * 256 + wc * 32 + 8 * fq;
        const float QS = 0.07216878364870322f * 1.4426950408889634f;
#pragma unroll
        for (int ai = 0; ai < 2; ++ai)
#pragma unroll
            for (int m = 0; m < 4; ++m) {
                const int row = u.pm * 256 + ai * 128 + wr * 64 + m * 16 + fr;
                const float rs = rsqrtf(ss[row] * (1.0f / 256.0f) + EPS_) * QS;
                const int pos = row & (SEQ_ - 1);
#pragma unroll
                for (int bj = 0; bj < 2; ++bj) {
                    const int col = cbase + bj * 128;
                    const int d = col % 192;
                    f32x4 v0 = acc[ai][bj][m][0] * rs, v1 = acc[ai][bj][m][1] * rs;
                    if (d >= 128) rope4(v0, v1, rope + pos * 32 + ((d - 128) >> 1));
                    *(u32x4*)(out + (size_t)row * 3072 + col) = pk8(v0, v1);
                }
            }
    }
};
}

struct WJob { const float* W; const float* gain; bf16_t* dst; int ldw, coloff, K, N, ldd, mode, rowoff; };
DI int wjob_row(const WJob& j, int n) {
    if (j.mode == 0) return j.rowoff + n;
    if (j.mode == 1) return j.rowoff + ((n < 32) ? 2 * n : 2 * (n - 32) + 1);
    const int hh = n / 192, d = n - hh * 192;
    if (d < 128) return n;
    const int r = d - 128;
    return hh * 192 + 128 + ((r < 32) ? 2 * r : 2 * (r - 32) + 1);
}
DI WJob get_job(const Params& p, int j) {
    unsigned char* ws = p.ws;
    bf16_t* HG = (bf16_t*)(ws + OFF_WHG); bf16_t* DKVQ = (bf16_t*)(ws + OFF_WDKVQ); bf16_t* UKV = (bf16_t*)(ws + OFF_WUKV);
    switch (j) {
        case 0: return WJob{p.w_q, p.hgrn_norm, HG, 1024, 0, 1024, 1024, 1024, 0, 0};
        case 1: return WJob{p.w_f, p.hgrn_norm, HG, 1024, 0, 1024, 1024, 1024, 0, 1024};
        case 2: return WJob{p.w_i, p.hgrn_norm, HG, 1024, 0, 1024, 1024, 1024, 0, 3072};
        case 3: return WJob{p.w_g, p.hgrn_norm, HG, 1024, 0, 1024, 1024, 1024, 0, 2048};
        case 4: return WJob{p.w_o, nullptr, (bf16_t*)(ws + OFF_WWO), 1024, 0, 1024, 1024, 1024, 0, 0};
        case 5: return WJob{p.w_up, p.mlp_norm, (bf16_t*)(ws + OFF_WUP0), 4096, 0, 1024, 4096, 1024, 0, 0};
        case 6: return WJob{p.w_down, nullptr, (bf16_t*)(ws + OFF_WDN0), 1024, 0, 4096, 1024, 4096, 0, 0};
        case 7: return WJob{p.w_dkv, p.kv_in_norm, DKVQ, 320, 0, 1024, 256, 1024, 0, 0};
        case 8: return WJob{p.w_dkv, p.kv_in_norm, DKVQ, 320, 256, 1024, 64, 1024, 1, 512};
        case 9: return WJob{p.w_dq, p.mla_norm, DKVQ, 256, 0, 1024, 256, 1024, 0, 256};
        case 10: return WJob{p.w_uk, p.kv_norm, UKV, 2048, 0, 256, 2048, 256, 0, 0};
        case 11: return WJob{p.w_uv, p.kv_norm, UKV, 2048, 0, 256, 2048, 256, 0, 2048};
        case 12: return WJob{p.w_uq, p.q_norm, (bf16_t*)(ws + OFF_WUQ), 3072, 0, 256, 3072, 256, 2, 0};
        case 13: return WJob{p.mla_w_o, nullptr, (bf16_t*)(ws + OFF_WMWO), 1024, 0, 2048, 1024, 2048, 0, 0};
        case 14: return WJob{p.w_up + (size_t)1024 * 4096, p.mlp_norm + 1024, (bf16_t*)(ws + OFF_WUP1), 4096, 0, 1024, 4096, 1024, 0, 0};
        default: return WJob{p.w_down + (size_t)4096 * 1024, nullptr, (bf16_t*)(ws + OFF_WDN1), 1024, 0, 4096, 1024, 4096, 0, 0};
    }
}

DI void prologue_phase(int wave_id, const Params& p, LAS unsigned char* lds) {
    const int tid = phase_tid(wave_id), lane = tid & 63, wid = tid >> 6;
    const int G = gridDim.x, c = blockIdx.x;
    unsigned char* ws = p.ws;
    {
        LAS float* tileA = (LAS float*)lds;
        LAS float* tileB = (LAS float*)(lds + 16640);
        const int tx = tid & 63, ty = tid >> 6;
        constexpr int total = 6480;
        float regA[8], regB[8];
        WJob ja = get_job(p, 0), jb2 = get_job(p, 0); int ak0 = 0, an0 = 0, bk0 = 0, bn0 = 0;
#define WDECODE(g_, jb_, k0_, n0_) do { const int gg_ = (g_); \
            const int j_ = gg_ >= 5456 ? 15 : gg_ >= 4432 ? 14 : gg_ >= 3920 ? 13 : gg_ >= 3728 ? 12 : gg_ >= 3600 ? 11 : gg_ >= 3472 ? 10 : gg_ >= 3408 ? 9 : gg_ >= 3392 ? 8 : gg_ >= 3328 ? 7 : gg_ >= 2304 ? 6 : gg_ >= 1280 ? 5 : (gg_ >> 8); \
            const int base_ = gg_ >= 5456 ? 5456 : gg_ >= 4432 ? 4432 : gg_ >= 3920 ? 3920 : gg_ >= 3728 ? 3728 : gg_ >= 3600 ? 3600 : gg_ >= 3472 ? 3472 : gg_ >= 3408 ? 3408 : gg_ >= 3392 ? 3392 : gg_ >= 3328 ? 3328 : gg_ >= 2304 ? 2304 : gg_ >= 1280 ? 1280 : ((gg_ >> 8) << 8); \
            jb_ = get_job(p, j_); const int t_ = gg_ - base_; const int tn_ = jb_.N / 64; k0_ = (t_ / tn_) * 64; n0_ = (t_ % tn_) * 64; } while (0)
#define WLOAD(reg_, jb_, k0_, n0_) do { _Pragma("unroll") for (int i = 0; i < 8; ++i) { const int k = ty + 8 * i; \
            reg_[i] = jb_.W[(size_t)(k0_ + k) * jb_.ldw + jb_.coloff + n0_ + tx]; } } while (0)
#define WSTORE(tile_, oj_, ok0_, on0_, gv_) do { _Pragma("unroll") for (int i = 0; i < 8; ++i) { const int n = ty + 8 * i; \
            oj_.dst[(size_t)wjob_row(oj_, on0_ + n) * oj_.ldd + ok0_ + tx] = bf16_1(tile_[tx * 65 + n] * gv_); } } while (0)
        int g = c;
        bool haveA = g < total, haveB = g + G < total;
        if (haveA) { WDECODE(g, ja, ak0, an0); WLOAD(regA, ja, ak0, an0); }
        if (haveB) { WDECODE(g + G, jb2, bk0, bn0); WLOAD(regB, jb2, bk0, bn0); }
        while (haveA) {
#pragma unroll
            for (int i = 0; i < 8; ++i) { tileA[(ty + 8 * i) * 65 + tx] = regA[i]; if (haveB) tileB[(ty + 8 * i) * 65 + tx] = regB[i]; }
            __syncthreads();
            const WJob oa = ja, ob = jb2; const int oak0 = ak0, oan0 = an0, obk0 = bk0, obn0 = bn0; const bool hadB = haveB;
            const float gva = oa.gain ? oa.gain[oak0 + tx] : 1.0f;
            const float gvb = (hadB && ob.gain) ? ob.gain[obk0 + tx] : 1.0f;
            g += 2 * G;
            haveA = g < total; haveB = g + G < total;
            if (haveA) { WDECODE(g, ja, ak0, an0); WLOAD(regA, ja, ak0, an0); }
            if (haveB) { WDECODE(g + G, jb2, bk0, bn0); WLOAD(regB, jb2, bk0, bn0); }
            WSTORE(tileA, oa, oak0, oan0, gva);
            if (hadB) WSTORE(tileB, ob, obk0, obn0, gvb);
            __syncthreads();
        }
#undef WDECODE
#undef WLOAD
#undef WSTORE
    }
    {
        bf16_t* xb = (bf16_t*)(ws + OFF_XB0); float* ssx = (float*)(ws + OFF_SS);
        for (int row = (c * 8 + wid) * 4; row < T_; row += G * 8 * 4) {
            f32x4 v[4][4];
#pragma unroll
            for (int rr = 0; rr < 4; ++rr)
#pragma unroll
                for (int i = 0; i < 4; ++i) v[rr][i] = *((const f32x4*)(p.x + (size_t)(row + rr) * 1024) + lane + 64 * i);
#pragma unroll
            for (int rr = 0; rr < 4; ++rr) {
                float sq = 0.f;
#pragma unroll
                for (int i = 0; i < 4; ++i) {
                    const f32x4 t = v[rr][i];
                    sq += (t[0] * t[0] + t[1] * t[1]) + (t[2] * t[2] + t[3] * t[3]);
                    u32x2 w; w.x = pk_bf16(t[0], t[1]); w.y = pk_bf16(t[2], t[3]);
                    *(u32x2*)(xb + (size_t)(row + rr) * 1024 + (lane + 64 * i) * 4) = w;
                }
#pragma unroll
                for (int o = 32; o >= 1; o >>= 1) sq += __shfl_xor(sq, o);
                if (lane == 0) ssx[row + rr] = sq;
            }
        }
    }
    {
        float* ss = (float*)(ws + OFF_SS) + T_;
        for (int i = c * 512 + tid; i < 6 * T_; i += G * 512) ss[i] = 0.f;
        u32x4* pad = (u32x4*)(ws + OFF_WDKVQ + (size_t)576 * 1024 * 2);
        for (int i = c * 512 + tid; i < 192 * 1024 * 2 / 16; i += G * 512) pad[i] = (u32x4){0u, 0u, 0u, 0u};
    }
    {
        f2_t* rope = (f2_t*)(ws + OFF_ROPE);
        for (int i = c * 512 + tid; i < SEQ_ * 32; i += G * 512) {
            const int pos = i >> 5, k = i & 31;
            const float invf = exp2f(-(float)k * (13.287712379549449f / 32.0f));
            const float ang = (float)pos * invf;
            double t = (double)ang * 0.15915494309189535;
            t -= __builtin_floor(t);
            const float fr = (float)t;
            rope[i] = (f2_t){__builtin_amdgcn_cosf(fr), __builtin_amdgcn_sinf(fr)};
        }
        float* lb = (float*)(ws + OFF_LB);
        for (int i = c * 512 + tid; i < 1024; i += G * 512) lb[i] = sigmoidf_(p.lb_logits[i] - p.lb_logits[1024 + i]);
    }
}

DI f32x4 mfma16(bf16x8 a, bf16x8 b, f32x4 c) { return __builtin_amdgcn_mfma_f32_16x16x32_bf16(a, b, c, 0, 0, 0); }
DI f32x16 mfma32(bf16x8 a, bf16x8 b, f32x16 c) { return __builtin_amdgcn_mfma_f32_32x32x16_bf16(a, b, c, 0, 0, 0); }

constexpr size_t OFF_SEND = OFF_B + 156 * MiB;
constexpr size_t OFF_DSEG = OFF_B + 172 * MiB;
DI void hgrn_phase1(int wave_id, const Params& p, LAS unsigned char* lds) {
    constexpr int QT = 0, KH = 17408, OB = 0, KT = 34816, VT = 53248, ST = 71680, PM = 106496, SEG = 115712, DEC = 119808;
    const int tid = phase_tid(wave_id), lane = tid & 63, wid = __builtin_amdgcn_readfirstlane(tid >> 6), fr = lane & 15, fq = lane >> 4;
    bf16_t* HQ = (bf16_t*)(p.ws + OFF_HQ);
    const bf16_t* HGl = (const bf16_t*)(p.ws + OFF_HQ + 64 * MiB);
    const bf16_t* HVt = (const bf16_t*)(p.ws + OFF_HQ + 128 * MiB);
    bf16_t* OL = (bf16_t*)p.out;
    const int dp = lane, seg = wid;
    for (int unit = blockIdx.x; unit < 256; unit += gridDim.x) {
        const int b = unit >> 5, h = (unit >> 2) & 7, sg = unit & 3, c0 = sg * 16;
        f32x4 Sacc[8];
#pragma unroll
        for (int i = 0; i < 8; ++i) Sacc[i] = (f32x4){0.f, 0.f, 0.f, 0.f};
        for (int i = tid; i < 34816 / 16; i += 512) *(LAS u32x4*)(lds + ST + i * 16) = (u32x4){0u, 0u, 0u, 0u};
        float cum0 = 0.f, cum1 = 0.f;
        unsigned q2[8], g2[8]; u32x4 vv[2];
#define HG_LOAD(c_) do { const size_t r0_ = (size_t)b * SEQ_ + (size_t)(c_) * 64; \
            _Pragma("unroll") for (int tt = 0; tt < 8; ++tt) { const size_t idx = (r0_ + seg * 8 + tt) * 1024 + h * 128 + 2 * dp; \
                q2[tt] = *(const unsigned*)(HQ + idx); g2[tt] = *(const unsigned*)(HGl + idx); } \
            const bf16_t* vb_ = HVt + ((size_t)((b * 64 + (c_)) * 8 + h)) * 8192; \
            vv[0] = *(const u32x4*)(vb_ + tid * 8); vv[1] = *(const u32x4*)(vb_ + 4096 + tid * 8); } while (0)
        HG_LOAD(c0);
        __syncthreads();
        for (int c = c0; c < c0 + 16; ++c) {
            const size_t row0 = (size_t)b * SEQ_ + (size_t)c * 64;
            float g[8][2], q[8][2], kk[8][2];
            float run0 = 0.f, run1 = 0.f;
#pragma unroll
            for (int tt = 0; tt < 8; ++tt) {
                const h2_t gh = __builtin_bit_cast(h2_t, g2[tt]);
                const float g0 = (float)gh[0], g1 = (float)gh[1];
                q[tt][0] = __uint_as_float(q2[tt] << 16); q[tt][1] = __uint_as_float(q2[tt] & 0xffff0000u);
                kk[tt][0] = 1.0f - fast_exp(g0); kk[tt][1] = 1.0f - fast_exp(g1);
                run0 += g0; run1 += g1; g[tt][0] = run0; g[tt][1] = run1;
            }
            *(LAS u32x4*)(lds + VT + ((tid >> 3) * 72 + (tid & 7) * 8) * 2) = vv[0];
            *(LAS u32x4*)(lds + VT + ((64 + (tid >> 3)) * 72 + (tid & 7) * 8) * 2) = vv[1];
            *(LAS f2_t*)(lds + SEG + (seg * 128 + 2 * dp) * 4) = (f2_t){run0, run1};
            __syncthreads();
            float off0 = 0.f, off1 = 0.f, tot0 = 0.f, tot1 = 0.f;
#pragma unroll
            for (int s8 = 0; s8 < 8; ++s8) { const f2_t xx = *(const LAS f2_t*)(lds + SEG + (s8 * 128 + 2 * dp) * 4); if (s8 < seg) { off0 += xx.x; off1 += xx.y; } tot0 += xx.x; tot1 += xx.y; }
            if (seg == 0) *(LAS f2_t*)(lds + DEC + 2 * dp * 4) = (f2_t){fast_exp(tot0), fast_exp(tot1)};
            const float ec0 = fast_exp(cum0), ec1 = fast_exp(cum1);
            float kt0[8], kt1[8];
#pragma unroll
            for (int tt = 0; tt < 8; ++tt) {
                const float b0 = off0 + g[tt][0], b1 = off1 + g[tt][1];
                const int t = seg * 8 + tt;
                const float qa = q[tt][0] * fast_exp(b0), qb_ = q[tt][1] * fast_exp(b1);
                *(LAS unsigned*)(lds + QT + (t * 136 + 2 * dp) * 2) = pk_bf16(qa, qb_);
                if (sg > 0) *(unsigned*)(HQ + (row0 + t) * 1024 + h * 128 + 2 * dp) = pk_bf16(qa * ec0, qb_ * ec1);
                *(LAS unsigned*)(lds + KH + (t * 136 + 2 * dp) * 2) = pk_bf16(kk[tt][0] * fast_exp(-b0), kk[tt][1] * fast_exp(-b1));
                kt0[tt] = kk[tt][0] * fast_exp(tot0 - b0); kt1[tt] = kk[tt][1] * fast_exp(tot1 - b1);
            }
            cum0 += tot0; cum1 += tot1;
            *(LAS u32x4*)(lds + KT + ((2 * dp) * 72 + seg * 8) * 2) = (u32x4){pk_bf16(kt0[0], kt0[1]), pk_bf16(kt0[2], kt0[3]), pk_bf16(kt0[4], kt0[5]), pk_bf16(kt0[6], kt0[7])};
            *(LAS u32x4*)(lds + KT + ((2 * dp + 1) * 72 + seg * 8) * 2) = (u32x4){pk_bf16(kt1[0], kt1[1]), pk_bf16(kt1[2], kt1[3]), pk_bf16(kt1[4], kt1[5]), pk_bf16(kt1[6], kt1[7])};
            if (c + 1 < c0 + 16) HG_LOAD(c + 1);
            __syncthreads();
#pragma unroll
            for (int ii = 0; ii < 2; ++ii) {
                const int idx = wid + 8 * ii, st = idx >> 2, tt = idx & 3;
                f32x4 a = (f32x4){0.f, 0.f, 0.f, 0.f};
                if (st <= tt) {
#pragma unroll
                    for (int ks = 0; ks < 4; ++ks) {
                        const bf16x8 ka = *(const LAS bf16x8*)(lds + KH + ((st * 16 + fr) * 136 + ks * 32 + fq * 8) * 2);
                        const bf16x8 qb = *(const LAS bf16x8*)(lds + QT + ((tt * 16 + fr) * 136 + ks * 32 + fq * 8) * 2);
                        a = mfma16(ka, qb, a);
                    }
                    if (st == tt) {
#pragma unroll
                        for (int j = 0; j < 4; ++j) if (fq * 4 + j > fr) a[j] = 0.f;
                    }
                }
                u32x2 w; w.x = pk_bf16(a[0], a[1]); w.y = pk_bf16(a[2], a[3]);
                *(LAS u32x2*)(lds + PM + ((tt * 16 + fr) * 72 + st * 16 + fq * 4) * 2) = w;
            }
            __syncthreads();
            const int ott = wid & 3, ovb = (wid >> 2) * 4;
            f32x4 oacc[4];
#pragma unroll
            for (int vi = 0; vi < 4; ++vi) {
                const int vt = ovb + vi;
                f32x4 a = (f32x4){0.f, 0.f, 0.f, 0.f};
#pragma unroll
                for (int ks = 0; ks < 4; ++ks) {
                    const bf16x8 sa = *(const LAS bf16x8*)(lds + ST + ((vt * 16 + fr) * 136 + ks * 32 + fq * 8) * 2);
                    const bf16x8 qb = *(const LAS bf16x8*)(lds + QT + ((ott * 16 + fr) * 136 + ks * 32 + fq * 8) * 2);
                    a = mfma16(sa, qb, a);
                }
#pragma unroll
                for (int ks = 0; ks < 2; ++ks) {
                    const bf16x8 va = *(const LAS bf16x8*)(lds + VT + ((vt * 16 + fr) * 72 + ks * 32 + fq * 8) * 2);
                    const bf16x8 pb = *(const LAS bf16x8*)(lds + PM + ((ott * 16 + fr) * 72 + ks * 32 + fq * 8) * 2);
                    a = mfma16(va, pb, a);
                }
                oacc[vi] = a;
            }
            {
                const f32x4 dec4 = *(const LAS f32x4*)(lds + DEC + (wid * 16 + fq * 4) * 4);
                bf16x8 ka[2];
#pragma unroll
                for (int ks = 0; ks < 2; ++ks) ka[ks] = *(const LAS bf16x8*)(lds + KT + ((wid * 16 + fr) * 72 + ks * 32 + fq * 8) * 2);
#pragma unroll
                for (int vt = 0; vt < 8; ++vt) {
                    f32x4 a = Sacc[vt] * dec4;
#pragma unroll
                    for (int ks = 0; ks < 2; ++ks) {
                        const bf16x8 vb = *(const LAS bf16x8*)(lds + VT + ((vt * 16 + fr) * 72 + ks * 32 + fq * 8) * 2);
                        a = mfma16(ka[ks], vb, a);
                    }
                    Sacc[vt] = a;
                }
            }
#pragma unroll
            for (int vi = 0; vi < 4; ++vi) { u32x2 w; w.x = pk_bf16(oacc[vi][0], oacc[vi][1]); w.y = pk_bf16(oacc[vi][2], oacc[vi][3]); *(u32x2*)(OL + (row0 + ott * 16 + fr) * 1024 + h * 128 + (ovb + vi) * 16 + fq * 4) = w; }
            __syncthreads();
#pragma unroll
            for (int vt = 0; vt < 8; ++vt) {
                u32x2 w; w.x = pk_bf16(Sacc[vt][0], Sacc[vt][1]); w.y = pk_bf16(Sacc[vt][2], Sacc[vt][3]);
                *(LAS u32x2*)(lds + ST + ((vt * 16 + fr) * 136 + wid * 16 + fq * 4) * 2) = w;
            }
        }
        float* send = (float*)(p.ws + OFF_SEND) + (size_t)unit * 16384;
#pragma unroll
        for (int vt = 0; vt < 8; ++vt)
#pragma unroll
            for (int j = 0; j < 4; ++j) send[(wid * 16 + fq * 4 + j) * 128 + vt * 16 + fr] = Sacc[vt][j];
        if (seg == 0) *(f2_t*)((float*)(p.ws + OFF_DSEG) + unit * 128 + 2 * dp) = (f2_t){fast_exp(cum0), fast_exp(cum1)};
        __syncthreads();
    }
#undef HG_LOAD
}

DI void hgrn_phase2(int wave_id, const Params& p, LAS unsigned char* lds) {
    constexpr int QT = 0, OB = 34816, ST = 71680;
    const int tid = phase_tid(wave_id), lane = tid & 63, wid = __builtin_amdgcn_readfirstlane(tid >> 6), fr = lane & 15, fq = lane >> 4;
    const bf16_t* HQ = (const bf16_t*)(p.ws + OFF_HQ);
    const bf16_t* HGt = (const bf16_t*)(p.ws + OFF_HQ + 192 * MiB);
    const bf16_t* OL = (const bf16_t*)p.out;
    bf16_t* OG = (bf16_t*)(p.ws + OFF_OG);
    const int er = tid >> 3, ep = tid & 7;
    for (int unit = blockIdx.x; unit < 256; unit += gridDim.x) {
        const int b = unit >> 5, h = (unit >> 2) & 7, sg = unit & 3, c0 = sg * 16;
        {
            const float* send = (const float*)(p.ws + OFF_SEND) + (size_t)(unit - sg) * 16384;
            const float* dsg = (const float*)(p.ws + OFF_DSEG) + (unit - sg) * 128;
#pragma unroll
            for (int i0 = 0; i0 < 32; i0 += 8) {
                float sv[8][3], dv[8][3];
#pragma unroll
                for (int i = 0; i < 8; ++i) {
                    const int e = tid + 512 * (i0 + i), d = e >> 7;
#pragma unroll
                    for (int s2 = 0; s2 < 3; ++s2) { sv[i][s2] = send[(size_t)s2 * 16384 + e]; dv[i][s2] = dsg[s2 * 128 + d]; }
                }
#pragma unroll
                for (int i = 0; i < 8; ++i) {
                    const int e = tid + 512 * (i0 + i), d = e >> 7, v = e & 127;
                    float S = 0.f;
#pragma unroll
                    for (int s2 = 0; s2 < 3; ++s2) { const bool on = s2 < sg; S = (on ? dv[i][s2] : 1.f) * S + (on ? sv[i][s2] : 0.f); }
                    *(LAS bf16_t*)(lds + ST + (v * 136 + d) * 2) = bf16_1(S);
                }
            }
        }
        u32x4 qv[2] = {(u32x4){0u, 0u, 0u, 0u}, (u32x4){0u, 0u, 0u, 0u}};
        if (sg > 0) {
            qv[0] = *(const u32x4*)(HQ + ((size_t)b * SEQ_ + (size_t)c0 * 64 + (tid >> 4)) * 1024 + h * 128 + (tid & 15) * 8);
            qv[1] = *(const u32x4*)(HQ + ((size_t)b * SEQ_ + (size_t)c0 * 64 + 32 + (tid >> 4)) * 1024 + h * 128 + (tid & 15) * 8);
        }
        u32x4 oaC, obC, oaN, obN; bf16x8 g0C, g1C, g0N, g1N;
        {
            const size_t e0 = ((size_t)b * SEQ_ + (size_t)c0 * 64 + er) * 1024 + h * 128 + ep * 16;
            oaC = *(const u32x4*)(OL + e0); obC = *(const u32x4*)(OL + e0 + 8); g0C = *(const bf16x8*)(HGt + e0); g1C = *(const bf16x8*)(HGt + e0 + 8);
            oaN = oaC; obN = obC; g0N = g0C; g1N = g1C;
        }
        for (int c = c0; c < c0 + 16; ++c) {
            const size_t row0 = (size_t)b * SEQ_ + (size_t)c * 64;
            *(LAS u32x4*)(lds + QT + ((tid >> 4) * 136 + (tid & 15) * 8) * 2) = qv[0];
            *(LAS u32x4*)(lds + QT + ((32 + (tid >> 4)) * 136 + (tid & 15) * 8) * 2) = qv[1];
            if (c + 1 < c0 + 16) {
                const size_t e1 = (row0 + 64 + er) * 1024 + h * 128 + ep * 16;
                oaN = *(const u32x4*)(OL + e1); obN = *(const u32x4*)(OL + e1 + 8); g0N = *(const bf16x8*)(HGt + e1); g1N = *(const bf16x8*)(HGt + e1 + 8);
            }
            f32x4 ol[4];
            {
                const u32x4 oa = oaC, ob = obC;
                ol[0] = (f32x4){__uint_as_float(oa.x << 16), __uint_as_float(oa.x & 0xffff0000u), __uint_as_float(oa.y << 16), __uint_as_float(oa.y & 0xffff0000u)};
                ol[1] = (f32x4){__uint_as_float(oa.z << 16), __uint_as_float(oa.z & 0xffff0000u), __uint_as_float(oa.w << 16), __uint_as_float(oa.w & 0xffff0000u)};
                ol[2] = (f32x4){__uint_as_float(ob.x << 16), __uint_as_float(ob.x & 0xffff0000u), __uint_as_float(ob.y << 16), __uint_as_float(ob.y & 0xffff0000u)};
                ol[3] = (f32x4){__uint_as_float(ob.z << 16), __uint_as_float(ob.z & 0xffff0000u), __uint_as_float(ob.w << 16), __uint_as_float(ob.w & 0xffff0000u)};
            }
            const bf16x8 gt0 = g0C, gt1 = g1C;
            __syncthreads();
            if (sg > 0 && c + 1 < c0 + 16) {
                qv[0] = *(const u32x4*)(HQ + (row0 + 64 + (tid >> 4)) * 1024 + h * 128 + (tid & 15) * 8);
                qv[1] = *(const u32x4*)(HQ + (row0 + 64 + 32 + (tid >> 4)) * 1024 + h * 128 + (tid & 15) * 8);
            }
            const int ott = wid & 3, ovb = (wid >> 2) * 4;
#pragma unroll
            for (int vi = 0; vi < 4; ++vi) {
                const int vt = ovb + vi;
                f32x4 a = (f32x4){0.f, 0.f, 0.f, 0.f};
                if (sg > 0) {
#pragma unroll
                    for (int ks = 0; ks < 4; ++ks) {
                        const bf16x8 sa = *(const LAS bf16x8*)(lds + ST + ((vt * 16 + fr) * 136 + ks * 32 + fq * 8) * 2);
                        const bf16x8 qb = *(const LAS bf16x8*)(lds + QT + ((ott * 16 + fr) * 136 + ks * 32 + fq * 8) * 2);
                        a = mfma16(sa, qb, a);
                    }
                }
                *(LAS f32x4*)(lds + OB + ((ott * 16 + fr) * 132 + vt * 16 + fq * 4) * 4) = a;
            }
            __syncthreads();
            {
                f32x4 ov[4]; float sq = 0.f;
#pragma unroll
                for (int i = 0; i < 4; ++i) { ov[i] = *(const LAS f32x4*)(lds + OB + (er * 132 + ep * 16 + i * 4) * 4) + ol[i]; sq += (ov[i][0] * ov[i][0] + ov[i][1] * ov[i][1]) + (ov[i][2] * ov[i][2] + ov[i][3] * ov[i][3]); }
                sq += __shfl_xor(sq, 1); sq += __shfl_xor(sq, 2); sq += __shfl_xor(sq, 4);
                const float sc = rsqrtf(sq * (1.0f / 128.0f) + EPS_);
                unsigned w[8];
#pragma unroll
                for (int i = 0; i < 4; ++i) {
                    const f32x4 gn = *(const f32x4*)(p.g_norm + ep * 16 + i * 4);
                    float r[4];
#pragma unroll
                    for (int j = 0; j < 4; ++j) {
                        const int e = i * 4 + j;
                        const float gate = bf2f((unsigned short)(e < 8 ? gt0[e] : gt1[e - 8]));
                        r[j] = ov[i][j] * sc * gn[j] * gate;
                    }
                    w[i * 2] = pk_bf16(r[0], r[1]); w[i * 2 + 1] = pk_bf16(r[2], r[3]);
                }
                bf16_t* op = OG + (row0 + er) * 1024 + h * 128 + ep * 16;
                *(u32x4*)op = (u32x4){w[0], w[1], w[2], w[3]};
                *(u32x4*)(op + 8) = (u32x4){w[4], w[5], w[6], w[7]};
            }
            oaC = oaN; obC = obN; g0C = g0N; g1C = g1N;
        }
        __syncthreads();
    }
}

struct AttU { int b, h, qb; };
DI void attn_unit(int wave_id, const bf16_t* Q, const bf16_t* KN, const bf16_t* KR, const bf16_t* VTg, bf16_t* O, const AttU u, const AttU nu, bool has_next,
                  bf16x8 (&qf)[12], u32x4 (&stg)[5], LAS unsigned char* lds) {
    constexpr int KSTR = 400, VSTR = 144, KBYTES = 64 * KSTR, STAGE = KBYTES + 128 * VSTR;
    const int tid = phase_tid(wave_id), lane = tid & 63, wid = __builtin_amdgcn_readfirstlane(tid >> 6), r = lane & 31, hh = lane >> 5;
    const int b = u.b, h = u.h, qb = u.qb;
    const int q0 = qb * 256 + wid * 32;
    f32x16 o[4];
#pragma unroll
    for (int i = 0; i < 4; ++i)
#pragma unroll
        for (int j = 0; j < 16; ++j) o[i][j] = 0.f;
    float m_run = -1e30f, l_run = 0.f;
    const int ntiles = 4 * qb + 4;
    const char* gKN = (const char*)(KN + (size_t)(b * SEQ_) * 2048 + h * 128);
    const char* gKR = (const char*)(KR + (size_t)(b * SEQ_) * 64);
    const char* gVT = (const char*)(VTg + (size_t)(b * 2048 + h * 128) * SEQ_);
    const unsigned gn0 = (unsigned)(((tid >> 4) * 2048 + (tid & 15) * 8) * 2), ln0 = (unsigned)((tid >> 4) * KSTR + (tid & 15) * 16);
    const unsigned gr0 = (unsigned)(tid * 16), lr0 = (unsigned)((tid >> 3) * KSTR + 256 + (tid & 7) * 16);
    const unsigned gv0 = (unsigned)(((tid >> 3) * SEQ_ + (tid & 7) * 8) * 2), lv0 = (unsigned)(KBYTES + (tid >> 3) * VSTR + (tid & 7) * 16);
#define ATT_LOADP(pKN_, pKR_, pVT_, kt_) do { \
        stg[0] = *(const u32x4*)((pKN_) + (size_t)(kt_) * (64 * 2048 * 2) + gn0); \
        stg[1] = *(const u32x4*)((pKN_) + (size_t)(kt_) * (64 * 2048 * 2) + 32 * 2048 * 2 + gn0); \
        stg[2] = *(const u32x4*)((pKR_) + (size_t)(kt_) * (64 * 64 * 2) + gr0); \
        stg[3] = *(const u32x4*)((pVT_) + (size_t)(kt_) * 128 + gv0); \
        stg[4] = *(const u32x4*)((pVT_) + (size_t)(kt_) * 128 + 64 * SEQ_ * 2 + gv0); } while (0)
#define ATT_LOAD(kt_) ATT_LOADP(gKN, gKR, gVT, kt_)
#define ATT_STORE(buf_) do { \
        *(LAS u32x4*)(lds + (buf_) + ln0) = stg[0]; *(LAS u32x4*)(lds + (buf_) + 32 * KSTR + ln0) = stg[1]; \
        *(LAS u32x4*)(lds + (buf_) + lr0) = stg[2]; \
        *(LAS u32x4*)(lds + (buf_) + lv0) = stg[3]; *(LAS u32x4*)(lds + (buf_) + 64 * VSTR + lv0) = stg[4]; } while (0)
    ATT_STORE(0);
    if (ntiles > 1) ATT_LOAD(1);
    __syncthreads();
    for (int kt = 0; kt < ntiles; ++kt) {
        const int cur = (kt & 1) * STAGE, nxt = ((kt + 1) & 1) * STAGE;
        const bool more = (kt + 1 < ntiles);
        __builtin_amdgcn_s_setprio(1);
        const int key0 = kt * 64;
        if (key0 <= q0 + 31) {
            const bool act1 = (key0 + 32 <= q0 + 31);
            f32x16 s0, s1;
#pragma unroll
            for (int j = 0; j < 16; ++j) { s0[j] = 0.f; s1[j] = 0.f; }
            const unsigned kb0 = cur + r * KSTR + 16 * hh, kb1 = kb0 + 32 * KSTR;
            if (act1) {
                bf16x8 ka[3], kc[3];
#pragma unroll
                for (int i = 0; i < 3; ++i) { ka[i] = *(const LAS bf16x8*)(lds + kb0 + 32 * i); kc[i] = *(const LAS bf16x8*)(lds + kb1 + 32 * i); }
#pragma unroll
                for (int ks = 0; ks < 12; ++ks) {
                    s0 = mfma32(ka[ks % 3], qf[ks], s0);
                    s1 = mfma32(kc[ks % 3], qf[ks], s1);
                    if (ks + 3 < 12) { ka[ks % 3] = *(const LAS bf16x8*)(lds + kb0 + 32 * (ks + 3)); kc[ks % 3] = *(const LAS bf16x8*)(lds + kb1 + 32 * (ks + 3)); }
                }
            } else {
                bf16x8 ka[4];
#pragma unroll
                for (int i = 0; i < 4; ++i) ka[i] = *(const LAS bf16x8*)(lds + kb0 + 32 * i);
#pragma unroll
                for (int ks = 0; ks < 12; ++ks) {
                    s0 = mfma32(ka[ks & 3], qf[ks], s0);
                    if (ks + 4 < 12) ka[ks & 3] = *(const LAS bf16x8*)(lds + kb0 + 32 * (ks + 4));
                }
            }
            const int qpos = q0 + r;
            if (key0 + 63 > q0) {
#pragma unroll
                for (int j = 0; j < 16; ++j) {
                    const int kr = (j & 3) + 8 * (j >> 2) + 4 * hh;
                    if (key0 + kr > qpos) s0[j] = -INFINITY;
                    if (!act1 || key0 + 32 + kr > qpos) s1[j] = -INFINITY;
                }
            }
            float mx = s0[0];
#pragma unroll
            for (int j = 1; j < 16; ++j) mx = fmaxf(mx, s0[j]);
#pragma unroll
            for (int j = 0; j < 16; ++j) mx = fmaxf(mx, s1[j]);
            { const u32x2 sw = __builtin_amdgcn_permlane32_swap(__float_as_uint(mx), __float_as_uint(mx), false, false);
              mx = fmaxf(__uint_as_float(sw.x), __uint_as_float(sw.y)); }
            const float m_new = fmaxf(m_run, mx);
            const bool grow = __builtin_amdgcn_ballot_w64(m_new > m_run) != 0ull;
            const float alpha = __builtin_amdgcn_exp2f(m_run - m_new);
            m_run = m_new;
            float rs = 0.f;
#pragma unroll
            for (int j = 0; j < 16; ++j) { s0[j] = __builtin_amdgcn_exp2f(s0[j] - m_new); rs += s0[j]; }
#pragma unroll
            for (int j = 0; j < 16; ++j) { s1[j] = __builtin_amdgcn_exp2f(s1[j] - m_new); rs += s1[j]; }
            if (grow) {
                l_run *= alpha;
#pragma unroll
                for (int i = 0; i < 4; ++i)
#pragma unroll
                    for (int j = 0; j < 16; ++j) o[i][j] *= alpha;
            }
            l_run += rs;
#pragma unroll
            for (int s2 = 0; s2 < 2; ++s2) {
                u32x4 pw;
                pw.x = pk_bf16(s0[8 * s2 + 0], s0[8 * s2 + 1]); pw.y = pk_bf16(s0[8 * s2 + 2], s0[8 * s2 + 3]);
                pw.z = pk_bf16(s0[8 * s2 + 4], s0[8 * s2 + 5]); pw.w = pk_bf16(s0[8 * s2 + 6], s0[8 * s2 + 7]);
                const bf16x8 pb = __builtin_bit_cast(bf16x8, pw);
#pragma unroll
                for (int vt = 0; vt < 4; ++vt) {
                    const bf16x8 vf = *(const LAS bf16x8*)(lds + cur + KBYTES + (32 * vt + r) * VSTR + (16 * s2 + 8 * hh) * 2);
                    o[vt] = mfma32(vf, pb, o[vt]);
                }
            }
            if (act1) {
#pragma unroll
                for (int s2 = 0; s2 < 2; ++s2) {
                    u32x4 pw;
                    pw.x = pk_bf16(s1[8 * s2 + 0], s1[8 * s2 + 1]); pw.y = pk_bf16(s1[8 * s2 + 2], s1[8 * s2 + 3]);
                    pw.z = pk_bf16(s1[8 * s2 + 4], s1[8 * s2 + 5]); pw.w = pk_bf16(s1[8 * s2 + 6], s1[8 * s2 + 7]);
                    const bf16x8 pb = __builtin_bit_cast(bf16x8, pw);
#pragma unroll
                    for (int vt = 0; vt < 4; ++vt) {
                        const bf16x8 vf = *(const LAS bf16x8*)(lds + cur + KBYTES + (32 * vt + r) * VSTR + (32 + 16 * s2 + 8 * hh) * 2);
                        o[vt] = mfma32(vf, pb, o[vt]);
                    }
                }
            }
        }
        __builtin_amdgcn_s_setprio(0);
        if (more) ATT_STORE(nxt);
        __builtin_amdgcn_s_setprio(1);
        if (kt + 2 < ntiles) ATT_LOAD(kt + 2);
        __syncthreads();
    }
    __builtin_amdgcn_s_setprio(0);
    if (has_next) {
        const bf16_t* qp = Q + ((size_t)(nu.b * SEQ_ + nu.qb * 256 + wid * 32 + r) * 3072 + nu.h * 192 + 8 * hh);
#pragma unroll
        for (int ks = 0; ks < 12; ++ks) qf[ks] = *(const bf16x8*)(qp + 16 * ks);
        const char* nKN = (const char*)(KN + (size_t)(nu.b * SEQ_) * 2048 + nu.h * 128);
        const char* nKR = (const char*)(KR + (size_t)(nu.b * SEQ_) * 64);
        const char* nVT = (const char*)(VTg + (size_t)(nu.b * 2048 + nu.h * 128) * SEQ_);
        ATT_LOADP(nKN, nKR, nVT, 0);
    }
    const u32x2 lsw = __builtin_amdgcn_permlane32_swap(__float_as_uint(l_run), __float_as_uint(l_run), false, false);
    const float lt = __uint_as_float(lsw.x) + __uint_as_float(lsw.y);
    const float inv = 1.0f / lt;
    bf16_t* op = O + ((size_t)(b * SEQ_ + q0 + r) * 3072 + h * 192);
#pragma unroll
    for (int vt = 0; vt < 4; ++vt)
#pragma unroll
        for (int gq = 0; gq < 4; ++gq) {
            u32x2 w; w.x = pk_bf16(o[vt][4 * gq] * inv, o[vt][4 * gq + 1] * inv); w.y = pk_bf16(o[vt][4 * gq + 2] * inv, o[vt][4 * gq + 3] * inv);
            *(u32x2*)(op + 32 * vt + 8 * gq + 4 * hh) = w;
        }
#undef ATT_LOAD
#undef ATT_LOADP
#undef ATT_STORE
}

DI AttU attn_sched(int i) {
    const int b = blockIdx.x & 7, j = blockIdx.x >> 3;
    return AttU{b, 2 * i + (j >> 4), (i & 1) ? (j & 15) : 15 - (j & 15)};
}

DI void attn_phase(int wave_id, const Params& p, LAS unsigned char* lds) {
    const bf16_t* Q = (const bf16_t*)(p.ws + OFF_Q);
    const bf16_t* KN = (const bf16_t*)(p.ws + OFF_KN);
    const bf16_t* KR = (const bf16_t*)(p.ws + OFF_KR);
    const bf16_t* VTg = (const bf16_t*)(p.ws + OFF_VT);
    bf16_t* O = (bf16_t*)(p.ws + OFF_Q);
    const int tid = phase_tid(wave_id), lane = tid & 63, wid = __builtin_amdgcn_readfirstlane(tid >> 6), r = lane & 31, hh = lane >> 5;
    bf16x8 qf[12]; u32x4 stg[5];
    const bool sched256 = gridDim.x == 256;
    const int nunits = sched256 ? 8 : (2048 - (int)blockIdx.x + (int)gridDim.x - 1) / (int)gridDim.x;
#define ATT_UNIT_OF(i_) (sched256 ? attn_sched(i_) : AttU{(int)((blockIdx.x + (i_) * gridDim.x) & 7), (int)(((blockIdx.x + (i_) * gridDim.x) >> 3) & 15), (int)((blockIdx.x + (i_) * gridDim.x) >> 7)})
    if (nunits > 0) {
        const AttU u0 = ATT_UNIT_OF(0);
        const bf16_t* qp = Q + ((size_t)(u0.b * SEQ_ + u0.qb * 256 + wid * 32 + r) * 3072 + u0.h * 192 + 8 * hh);
#pragma unroll
        for (int ks = 0; ks < 12; ++ks) qf[ks] = *(const bf16x8*)(qp + 16 * ks);
        const char* nKN = (const char*)(KN + (size_t)(u0.b * SEQ_) * 2048 + u0.h * 128);
        const char* nKR = (const char*)(KR + (size_t)(u0.b * SEQ_) * 64);
        const char* nVT = (const char*)(VTg + (size_t)(u0.b * 2048 + u0.h * 128) * SEQ_);
        stg[0] = *(const u32x4*)(nKN + (unsigned)(((tid >> 4) * 2048 + (tid & 15) * 8) * 2));
        stg[1] = *(const u32x4*)(nKN + 32 * 2048 * 2 + (unsigned)(((tid >> 4) * 2048 + (tid & 15) * 8) * 2));
        stg[2] = *(const u32x4*)(nKR + (unsigned)(tid * 16));
        stg[3] = *(const u32x4*)(nVT + (unsigned)(((tid >> 3) * SEQ_ + (tid & 7) * 8) * 2));
        stg[4] = *(const u32x4*)(nVT + 64 * SEQ_ * 2 + (unsigned)(((tid >> 3) * SEQ_ + (tid & 7) * 8) * 2));
    }
    for (int i = 0; i < nunits; ++i)
        attn_unit(wave_id, Q, KN, KR, VTg, O, ATT_UNIT_OF(i), ATT_UNIT_OF(i + 1 < nunits ? i + 1 : i), i + 1 < nunits, qf, stg, lds);
#undef ATT_UNIT_OF
}

DI void final_phase(int wave_id, const Params& p) {
    const int tid = phase_tid(wave_id), lane = tid & 63, wid = tid >> 6;
    const float* ss = (const float*)(p.ws + OFF_SS) + 4 * (size_t)T_;
    const bf16_t* hb = (const bf16_t*)(p.ws + OFF_XB3);
    for (int row = blockIdx.x * 8 + wid; row < T_; row += gridDim.x * 8) {
        const float rs = rsqrtf(ss[row] * (1.0f / 1024.0f) + EPS_);
        f32x4* orow = (f32x4*)(p.out + (size_t)row * 1024);
#pragma unroll
        for (int i = 0; i < 2; ++i) {
            const int c8 = lane + 64 * i;
            const u32x4 hv = *(const u32x4*)(hb + (size_t)row * 1024 + c8 * 8);
            const f32x4 g0 = *(const f32x4*)(p.final_norm + c8 * 8), g1 = *(const f32x4*)(p.final_norm + c8 * 8 + 4);
            orow[c8 * 2] = (f32x4){__uint_as_float(hv.x << 16), __uint_as_float(hv.x & 0xffff0000u), __uint_as_float(hv.y << 16), __uint_as_float(hv.y & 0xffff0000u)} * rs * g0;
            orow[c8 * 2 + 1] = (f32x4){__uint_as_float(hv.z << 16), __uint_as_float(hv.z & 0xffff0000u), __uint_as_float(hv.w << 16), __uint_as_float(hv.w & 0xffff0000u)} * rs * g1;
        }
    }
}

__global__ void __launch_bounds__(512) fwd_megakernel(Params p) {
    extern __shared__ __attribute__((aligned(16))) unsigned char lds_raw[];
    LAS unsigned char* lds = (LAS unsigned char*)lds_raw;
    cg::grid_group grid = cg::this_grid();
    const int wave_id = __builtin_amdgcn_readfirstlane(threadIdx.x >> 6);
    using namespace pg8;
    {
        const int t0 = phase_tid(wave_id);
        if (t0 == 0) { *(LAS u32x4*)(lds + 131072) = (u32x4){0u, 0u, 0u, 0u}; }
        __syncthreads();
    }
    const XcdBarrier xb = xcd_barrier_post((unsigned*)(p.ws + OFF_BAR), (volatile LAS unsigned*)(lds + 131072), phase_tid(wave_id));
#ifndef PHASE_MASK
#define PHASE_MASK 0xffff
#endif
#define PH(i) if ((PHASE_MASK >> (i)) & 1)
#define WSDEF unsigned char* ws = p.ws; asm volatile("" : "+s"(ws)); float* SS = (float*)(ws + OFF_SS); \
    float *ss_x = SS, *ss_h1 = SS + T_, *ss_h2 = SS + 2 * T_, *ss_h3 = SS + 3 * T_, *ss_h4 = SS + 4 * T_, *ss_ckv = SS + 5 * T_, *ss_cq = SS + 6 * T_; \
    bf16_t* XB0 = (bf16_t*)(ws + OFF_XB0); const f2_t* rope = (const f2_t*)(ws + OFF_ROPE); \
    (void)ss_x; (void)ss_h1; (void)ss_h2; (void)ss_h3; (void)ss_h4; (void)ss_ckv; (void)ss_cq; (void)XB0; (void)rope;
    PH(0) prologue_phase(wave_id, p, lds);
    if (p.ws == nullptr) grid.sync();
    xcd_barrier(xb, phase_tid(wave_id));
    PH(1) { WSDEF gemm_phase(wave_id, lds, Gemm{XB0, (const bf16_t*)(ws + OFF_WHG), T_, 3072, 1024, 1024, 256, 0}, EpiHG{ss_x, (const float*)(ws + OFF_LB), (bf16_t*)(ws + OFF_HQ)}); }
    PH(1) { WSDEF gemm_phase(wave_id, lds, Gemm{(const bf16_t*)(ws + OFF_WHG) + (size_t)3072 * 1024, XB0, 1024, T_, 1024, 1024, 256, 0}, EpiHVT{ss_x, (bf16_t*)(ws + OFF_HQ + 128 * MiB)}); }
    xcd_barrier(xb, phase_tid(wave_id));
    PH(2) hgrn_phase1(wave_id, p, lds);
    xcd_barrier(xb, phase_tid(wave_id));
    PH(2) hgrn_phase2(wave_id, p, lds);
    xcd_barrier(xb, phase_tid(wave_id));
    PH(3) { WSDEF gemm_phase(wave_id, lds, Gemm{(const bf16_t*)(ws + OFF_OG), (const bf16_t*)(ws + OFF_WWO), T_, 1024, 1024, 1024, 256, 0}, EpiRes<false>{XB0, XB0, ss_h1}); }
    xcd_barrier(xb, phase_tid(wave_id));
    PH(4) { WSDEF gemm_phase(wave_id, lds, Gemm{XB0, (const bf16_t*)(ws + OFF_WUP0), T_, 4096, 1024, 1024, 256, 0}, EpiRelu2{ss_h1, (bf16_t*)(ws + OFF_HID0)}); }
    xcd_barrier(xb, phase_tid(wave_id));
    PH(5) { WSDEF gemm_phase(wave_id, lds, Gemm{(const bf16_t*)(ws + OFF_HID0), (const bf16_t*)(ws + OFF_WDN0), T_, 1024, 4096, 4096, 256, 1}, EpiRes<false>{XB0, (bf16_t*)p.out, ss_h2}); }
    xcd_barrier(xb, phase_tid(wave_id));
    PH(6) { WSDEF gemm_phase(wave_id, lds, Gemm{(const bf16_t*)p.out, (const bf16_t*)(ws + OFF_WDKVQ), T_, 768, 1024, 1024, 256, 0},
               EpiDKVQ{ss_h2, (bf16_t*)(ws + OFF_CKV), (bf16_t*)(ws + OFF_CQ), (bf16_t*)(ws + OFF_KR), ss_ckv, ss_cq, rope}); }
    xcd_barrier(xb, phase_tid(wave_id));
    PH(7) { WSDEF gemm_phase(wave_id, lds, Gemm{(const bf16_t*)(ws + OFF_CKV), (const bf16_t*)(ws + OFF_WUKV), T_, 2048, 256, 256, 256, 0}, EpiKN{ss_ckv, (bf16_t*)(ws + OFF_KN)}); }
    PH(8) { WSDEF gemm_phase(wave_id, lds, Gemm{(const bf16_t*)(ws + OFF_WUKV) + (size_t)2048 * 256, (const bf16_t*)(ws + OFF_CKV), 2048, T_, 256, 256, 256, 0}, EpiVT{ss_ckv, (bf16_t*)(ws + OFF_VT)}); }
    PH(9) { WSDEF gemm_phase(wave_id, lds, Gemm{(const bf16_t*)(ws + OFF_CQ), (const bf16_t*)(ws + OFF_WUQ), T_, 3072, 256, 256, 256, 0}, EpiQ{ss_cq, (bf16_t*)(ws + OFF_Q), rope}); }
    xcd_barrier(xb, phase_tid(wave_id));
    PH(10) attn_phase(wave_id, p, lds);
    xcd_barrier(xb, phase_tid(wave_id));
    PH(11) { WSDEF gemm_phase(wave_id, lds, Gemm{(const bf16_t*)(ws + OFF_Q), (const bf16_t*)(ws + OFF_WMWO), T_, 1024, 2048, 3072, 384, 0}, EpiRes<false>{(const bf16_t*)p.out, (bf16_t*)(ws + OFF_XB3), ss_h3}); }
    xcd_barrier(xb, phase_tid(wave_id));
    PH(12) { WSDEF gemm_phase(wave_id, lds, Gemm{(const bf16_t*)(ws + OFF_XB3), (const bf16_t*)(ws + OFF_WUP1), T_, 4096, 1024, 1024, 256, 0}, EpiRelu2{ss_h3, (bf16_t*)(ws + OFF_HID1)}); }
    xcd_barrier(xb, phase_tid(wave_id));
    PH(13) { WSDEF gemm_phase(wave_id, lds, Gemm{(const bf16_t*)(ws + OFF_HID1), (const bf16_t*)(ws + OFF_WDN1), T_, 1024, 4096, 4096, 256, 1}, EpiRes<false>{(const bf16_t*)(ws + OFF_XB3), (bf16_t*)(ws + OFF_XB3), ss_h4}); }
    xcd_barrier(xb, phase_tid(wave_id));
    PH(14) final_phase(wave_id, p);
}

extern "C" void kernel_launch(void* const* d_in, const int* in_sizes, int n_in, void* d_out, int out_size, void* d_ws, size_t ws_size, hipStream_t stream) {
    static int grid_blocks = 0;
    if (!grid_blocks) {
        int dev = 0, cus = 0, per_cu = 0;
        hipGetDevice(&dev);
        hipDeviceGetAttribute(&cus, hipDeviceAttributeMultiprocessorCount, dev);
        if (hipFuncSetAttribute((const void*)fwd_megakernel, hipFuncAttributeMaxDynamicSharedMemorySize, LDS_BYTES) != hipSuccess) fprintf(stderr, "hipFuncSetAttribute failed\n");
        hipOccupancyMaxActiveBlocksPerMultiprocessor(&per_cu, (const void*)fwd_megakernel, 512, LDS_BYTES);
        if (per_cu < 1) per_cu = 1;
        grid_blocks = cus * per_cu;
        if (grid_blocks > 256) grid_blocks = 256;
        if (ws_size < WS_NEED) fprintf(stderr, "workspace too small: %zu < %zu\n", ws_size, (size_t)WS_NEED);
    }
    Params p{};
    const float** pp = (const float**)&p;
    for (int i = 0; i < 23; ++i) pp[i] = (const float*)d_in[i];
    p.out = (float*)d_out;
    p.ws = (unsigned char*)d_ws;
    hipMemsetAsync((unsigned char*)d_ws + OFF_BAR, 0, XCD_BAR_WORDS * 4, stream);
    void* args[] = {&p};
    hipError_t e = hipLaunchCooperativeKernel((const void*)fwd_megakernel, dim3(grid_blocks), dim3(512), args, LDS_BYTES, stream);
    if (e != hipSuccess) fprintf(stderr, "cooperative launch failed: %s (grid %d)\n", hipGetErrorString(e), grid_blocks);
}
```
